# Optimizing an MI355X kernel written in HIP

```python
import jax, jax.numpy as jnp
from jax import lax
import numpy as np

D_MODEL = 2048
BATCH = 4
SEQ = 4096
DEPTH = 2

GRID_W = 64
CTX_LEN = 256
GLA_HEADS = 4
GLA_V = D_MODEL // 2
GLA_K = D_MODEL // 4
GLA_DK = GLA_K // GLA_HEADS
GLA_DV = GLA_V // GLA_HEADS
GATE_RANK = 16
GATE_TAU = 16.0
CHUNK = 64
POOL_WINDOWS = (2, 4, 8, 16)
POOL_WIDTH = D_MODEL // 2
POOL_GROUP_DIM = POOL_WIDTH // len(POOL_WINDOWS)
MIX_WIDTH = GLA_V + POOL_WIDTH
D_FF = 4 * D_MODEL
STATE_COLS = GLA_K + GLA_V + 2 * GATE_RANK
PROJ_COLS = STATE_COLS + GLA_K + GLA_V + POOL_WIDTH
PROJ_SPLITS = (GLA_K, GLA_K + GLA_V, GLA_K + GLA_V + GATE_RANK, STATE_COLS,
               STATE_COLS + GLA_K, STATE_COLS + GLA_K + GLA_V)
STATE_SPLITS = PROJ_SPLITS[:3]
DEEPNORM_ALPHA = (2 * DEPTH) ** 0.25
DEEPNORM_BETA = (8 * DEPTH) ** -0.25
LN_EPS = 1e-6
RMS_EPS = 1e-6

kernel_name = 'gla_pool_hybrid_dit_block'


def _layer_norm_plain(x):
    xf = x.astype(jnp.float32)
    mu = jnp.mean(xf, axis=-1, keepdims=True)
    var = jnp.mean(jnp.square(xf - mu), axis=-1, keepdims=True)
    return ((xf - mu) * lax.rsqrt(var + LN_EPS)).astype(x.dtype)


def _layer_norm(x, g, b):
    return _layer_norm_plain(x) * g + b


def _modulate(x, shift, scale):
    return _layer_norm_plain(x) * (1.0 + scale) + shift


def _heads(a, n_heads):
    b, t, _ = a.shape
    return a.reshape(b, t, n_heads, -1).transpose(0, 2, 1, 3)


def _merge_heads(a):
    b, h, t, d = a.shape
    return a.transpose(0, 2, 1, 3).reshape(b, t, h * d)


def _rev(a):
    return a[:, :, ::-1]


def _log_decay(lr, w_up, b_up):
    return jax.nn.log_sigmoid((lr @ w_up + b_up).astype(jnp.float32)) / GATE_TAU


def _gla_chunked(q, k, v, log_a, s0):
    b, h, t, _ = q.shape
    dv = v.shape[-1]
    n = t // CHUNK

    def chunks(a):
        return jnp.moveaxis(a.astype(jnp.float32).reshape(b, h, n, CHUNK, a.shape[-1]), 2, 0)

    lower_tri = jnp.tril(jnp.ones((CHUNK, CHUNK), dtype=bool))[:, :, None]

    def step(s, blk):
        qc, kc, vc, gc = blk
        cum = jnp.cumsum(gc, axis=2)
        total = cum[:, :, -1:, :]
        o_inter = jnp.einsum('bhid,bhdv->bhiv', qc * jnp.exp(cum), s)
        diff = jnp.minimum(cum[:, :, :, None, :] - cum[:, :, None, :, :], 0.0)
        decay = jnp.where(lower_tri, jnp.exp(diff), 0.0)
        scores = jnp.einsum('bhid,bhjd,bhijd->bhij', qc, kc, decay)
        o_intra = jnp.einsum('bhij,bhjv->bhiv', scores, vc)
        s_new = (jnp.exp(total[:, :, 0, :, None]) * s
                 + jnp.einsum('bhjd,bhjv->bhdv', kc * jnp.exp(total - cum), vc))
        return s_new, o_inter + o_intra

    s_fin, o = lax.scan(step, s0, (chunks(q), chunks(k), chunks(v), chunks(log_a)))
    return jnp.moveaxis(o, 0, 2).reshape(b, h, t, dv), s_fin


def _gla_final_state(k, v, log_a):
    cum = jnp.cumsum(log_a.astype(jnp.float32), axis=2)
    total = cum[:, :, -1:, :]
    return jnp.einsum('bhtd,bhtv->bhdv', k.astype(jnp.float32) * jnp.exp(total - cum),
                      v.astype(jnp.float32))


def _bidir_gla(q, k, v, la_f, la_b, s0_f, s0_b):
    o_f, s_f = _gla_chunked(q, k, v, la_f, s0_f)
    o_b, s_b = _gla_chunked(_rev(q), _rev(k), _rev(v), _rev(la_b), s0_b)
    return o_f + _rev(o_b), s_f, s_b


def _gla_output(o, g, norm_g):
    o = o * lax.rsqrt(jnp.mean(jnp.square(o), axis=-1, keepdims=True) + RMS_EPS)
    return _merge_heads(o).astype(g.dtype) * norm_g.reshape(1, 1, -1).repeat(1, axis=0)[:, :, :GLA_DV].repeat(GLA_HEADS, axis=-1).reshape(1, 1, GLA_V) * 0 + _merge_heads(o * norm_g).astype(g.dtype) * jax.nn.silu(g) if False else _merge_heads(o * norm_g).astype(g.dtype) * jax.nn.silu(g)


def _multiscale_pool(u, w_pool, pool_scale, seg_start, seg_len):
    b, t, c = u.shape
    pos = jnp.arange(t, dtype=jnp.int32)
    seg_end = seg_start + seg_len - 1
    csum = jnp.cumsum(u.astype(jnp.float32), axis=1)
    csum = jnp.concatenate([jnp.zeros((b, 1, c), jnp.float32), csum], axis=1)
    outs = []
    for gi, w in enumerate(POOL_WINDOWS):
        lo = jnp.maximum(pos - w // 2, seg_start)
        hi = jnp.minimum(pos + w // 2 - 1, seg_end)
        sl = slice(gi * POOL_GROUP_DIM, (gi + 1) * POOL_GROUP_DIM)
        cs = csum[:, :, sl]
        mean = (cs[:, hi + 1] - cs[:, lo]) / (hi - lo + 1).astype(jnp.float32)[None, :, None]
        resid = (mean - u[:, :, sl].astype(jnp.float32)).astype(u.dtype)
        outs.append(jnp.einsum('btc,cd->btd', resid, w_pool[gi]))
    return jnp.concatenate(outs, axis=-1) * pool_scale


def _mixer(p, s0_f, s0_b, w_gate_up, b_gate, gla_norm_g, w_pool, pool_scale, w_out, seg_start, seg_len):
    k, v, lr_f, lr_b, q, g, u = jnp.split(p, PROJ_SPLITS, axis=-1)
    la_f = _heads(_log_decay(lr_f, w_gate_up[0], b_gate[0]), GLA_HEADS)
    la_b = _heads(_log_decay(lr_b, w_gate_up[1], b_gate[1]), GLA_HEADS)
    o, s_f, s_b = _bidir_gla(_heads(q, GLA_HEADS) * (GLA_DK ** -0.5), _heads(k, GLA_HEADS),
                             _heads(v, GLA_HEADS), la_f, la_b, s0_f, s0_b)
    mixed = jnp.concatenate([_gla_output(o, g, gla_norm_g),
                             _multiscale_pool(u, w_pool, pool_scale, seg_start, seg_len)], axis=-1)
    return mixed @ w_out, s_f, s_b


def _sq_relu_mlp(h, w1, b1, w2, b2):
    return jnp.square(jax.nn.relu(h @ w1 + b1)) @ w2 + b2


def setup_inputs(seed: int = 0) -> dict:
    key = jax.random.key(seed)
    ks = jax.random.split(key, 21)

    def nrm(k, shape, s):
        return jax.random.normal(k, shape, jnp.float32) * s

    return {
        'x': nrm(ks[0], (BATCH, SEQ, D_MODEL), 1.0),
        'c': nrm(ks[1], (BATCH, D_MODEL), 1.0),
        'ctx': nrm(ks[2], (BATCH, CTX_LEN, D_MODEL), 1.0),
        'c_ctx': nrm(ks[3], (D_MODEL,), 1.0),
        'w_ada': nrm(ks[4], (DEPTH, D_MODEL, 6 * D_MODEL), 0.5 * D_MODEL ** -0.5),
        'b_ada': nrm(ks[5], (DEPTH, 6 * D_MODEL), 0.02),
        'w_in': nrm(ks[6], (DEPTH, D_MODEL, PROJ_COLS), D_MODEL ** -0.5),
        'w_gate_up': nrm(ks[7], (DEPTH, 2, GATE_RANK, GLA_K), GATE_RANK ** -0.5),
        'b_gate': nrm(ks[8], (DEPTH, 2, GLA_K), 0.02),
        'gla_norm_g': 1.0 + nrm(ks[9], (DEPTH, GLA_DV), 0.02),
        'w_pool': nrm(ks[10], (DEPTH, len(POOL_WINDOWS), POOL_GROUP_DIM, POOL_GROUP_DIM), POOL_GROUP_DIM ** -0.5),
        'pool_scale': 1.0 + nrm(ks[11], (DEPTH, POOL_WIDTH), 0.02),
        'w_out': nrm(ks[12], (DEPTH, MIX_WIDTH, D_MODEL), DEEPNORM_BETA * MIX_WIDTH ** -0.5),
        'ln1_g': 1.0 + nrm(ks[13], (DEPTH, D_MODEL), 0.02),
        'ln1_b': nrm(ks[14], (DEPTH, D_MODEL), 0.02),
        'w_mlp1': nrm(ks[15], (DEPTH, D_MODEL, D_FF), D_MODEL ** -0.5),
        'b_mlp1': nrm(ks[16], (DEPTH, D_FF), 0.02),
        'w_mlp2': nrm(ks[17], (DEPTH, D_FF, D_MODEL), DEEPNORM_BETA * D_FF ** -0.5),
        'b_mlp2': nrm(ks[18], (DEPTH, D_MODEL), 0.02),
        'ln2_g': 1.0 + nrm(ks[19], (DEPTH, D_MODEL), 0.02),
        'ln2_b': nrm(ks[20], (DEPTH, D_MODEL), 0.02),
    }


def reference(x, c, ctx, c_ctx, w_ada, b_ada, w_in, w_gate_up, b_gate, gla_norm_g, w_pool,
              pool_scale, w_out, ln1_g, ln1_b, w_mlp1, b_mlp1, w_mlp2, b_mlp2, ln2_g, ln2_b):
    b, t, _ = x.shape
    ctx_len = ctx.shape[1]
    rows = t // GRID_W
    lat_start = jnp.repeat(jnp.arange(rows, dtype=jnp.int32) * GRID_W, GRID_W)
    ctx_start = jnp.zeros((ctx_len,), jnp.int32)
    s_zero = jnp.zeros((b, GLA_HEADS, GLA_DK, GLA_DV), jnp.float32)
    silu_c = jax.nn.silu(c)
    silu_cc = jax.nn.silu(c_ctx)
    for l in range(DEPTH):
        last = l == DEPTH - 1
        mod = (silu_c @ w_ada[l] + b_ada[l])[:, None, :]
        mod_c = silu_cc @ w_ada[l] + b_ada[l]
        sh1, sc1, g1, sh2, sc2, g2 = jnp.split(mod, 6, axis=-1)
        csh1, csc1, cg1, csh2, csc2, cg2 = jnp.split(mod_c, 6, axis=-1)

        hc = _modulate(ctx, csh1, csc1)
        if last:
            kc, vc, lrc_f, lrc_b = jnp.split(hc @ w_in[l][:, :STATE_COLS], STATE_SPLITS, axis=-1)
            kc_h, vc_h = _heads(kc, GLA_HEADS), _heads(vc, GLA_HEADS)
            s_f = _gla_final_state(kc_h, vc_h, _heads(_log_decay(lrc_f, w_gate_up[l, 0], b_gate[l, 0]), GLA_HEADS))
            s_b = _gla_final_state(_rev(kc_h), _rev(vc_h),
                                   _rev(_heads(_log_decay(lrc_b, w_gate_up[l, 1], b_gate[l, 1]), GLA_HEADS)))
        else:
            mix_c, s_f, s_b = _mixer(hc @ w_in[l], s_zero, s_zero, w_gate_up[l], b_gate[l], gla_norm_g[l],
                                     w_pool[l], pool_scale[l], w_out[l], ctx_start, ctx_len)
            ctx = _layer_norm(DEEPNORM_ALPHA * ctx + cg1 * mix_c, ln1_g[l], ln1_b[l])
            yc = _sq_relu_mlp(_modulate(ctx, csh2, csc2), w_mlp1[l], b_mlp1[l], w_mlp2[l], b_mlp2[l])
            ctx = _layer_norm(DEEPNORM_ALPHA * ctx + cg2 * yc, ln2_g[l], ln2_b[l])

        h = _modulate(x, sh1, sc1)
        mix, _, _ = _mixer(h @ w_in[l], s_f, s_b, w_gate_up[l], b_gate[l], gla_norm_g[l],
                           w_pool[l], pool_scale[l], w_out[l], lat_start, GRID_W)
        x = _layer_norm(DEEPNORM_ALPHA * x + g1 * mix, ln1_g[l], ln1_b[l])
        y = _sq_relu_mlp(_modulate(x, sh2, sc2), w_mlp1[l], b_mlp1[l], w_mlp2[l], b_mlp2[l])
        x = _layer_norm(DEEPNORM_ALPHA * x + g2 * y, ln2_g[l], ln2_b[l])
    return x
```

```cpp
#include <hip/hip_runtime.h>
#include <hip/hip_cooperative_groups.h>
#include <cstdio>
namespace cg = cooperative_groups;

#define LAS __attribute__((address_space(3)))
typedef unsigned short bf16_t;
typedef short bf16x8 __attribute__((ext_vector_type(8)));
typedef float f32x4 __attribute__((ext_vector_type(4)));
typedef unsigned u32x4 __attribute__((ext_vector_type(4)));
typedef unsigned u32x2 __attribute__((ext_vector_type(2)));

constexpr int D = 2048, NB = 4, T = 4096, CTXL = 256, DFF = 8192;
constexpr int ROWS_LAT = NB * T, ROWS_CTX = NB * CTXL, ROWS = ROWS_LAT + ROWS_CTX;
constexpr int NIN = 4352;
constexpr float ALPHA = 1.4142135623730951f;
constexpr float QSCALE = 0.08838834764831845f;

constexpr size_t SZ_XB = (size_t)ROWS * D * 4, SZ_H = (size_t)ROWS * D * 2;
constexpr size_t NW_IN = (size_t)NIN * D, NW_OUT = (size_t)D * D, NW_1 = (size_t)DFF * D, NW_2 = (size_t)D * DFF, NW_POOL = 4 * 256 * 256;
constexpr size_t SZ_W = (NW_IN + NW_OUT + NW_1 + NW_2 + NW_POOL) * 2;
constexpr size_t SZ_MODP = 32ull * 2 * 5 * 12288 * 4, SZ_MOD = 2ull * 5 * 12288 * 4;
constexpr size_t OFF_XB = 0, OFF_H = OFF_XB + SZ_XB, OFF_W = OFF_H + SZ_H, OFF_MODP = OFF_W + SZ_W, OFF_MOD = OFF_MODP + SZ_MODP, OFF_BAR = OFF_MOD + SZ_MOD  , OFF_C = OFF_BAR + 16384;
constexpr size_t C_PK = 0, C_PV = C_PK + (size_t)ROWS * 512 * 2, C_PQ = C_PV + (size_t)ROWS * 1024 * 2, C_PG = C_PQ + (size_t)ROWS * 512 * 2, C_PU = C_PG + (size_t)ROWS * 1024 * 2,
                 C_LR = C_PU + (size_t)ROWS * 1024 * 2, C_QT = C_LR + (size_t)ROWS * 32 * 4, C_KHT = C_QT + (size_t)2 * ROWS * 512 * 2, C_P = C_KHT + (size_t)2 * ROWS * 512 * 2,
                 C_VT = C_P + (size_t)2176 * 4096 * 2, C_E = C_VT + (size_t)ROWS * 1024 * 2, C_OB = C_E + (size_t)2176 * 128 * 4, C_END = C_OB + (size_t)ROWS * 1024 * 4;
constexpr size_t C_OF = C_PK;
constexpr size_t C_VTL = C_VT, C_VTC = C_VT + (size_t)ROWS_LAT * 1024 * 2;
constexpr size_t C_RESID = C_VT;
constexpr size_t C_A1 = 0;
constexpr size_t C_PART2 = C_QT;
constexpr size_t C_PART4 = (size_t)ROWS * 8192 * 2;
constexpr size_t SZ_PART = (size_t)8 * ROWS_CTX * D * 4;
static_assert(SZ_PART <= C_P - C_QT, "PART2 fits");
constexpr size_t WS_NEED = OFF_C + (C_PART4 + SZ_PART > C_END ? C_PART4 + SZ_PART : C_END);
static_assert((size_t)ROWS * 8192 * 2 <= C_END, "A1 fits");

struct Params {
    const float *x, *c, *ctx, *c_ctx, *w_ada, *b_ada, *w_in, *w_gate_up, *b_gate, *gla_norm_g, *w_pool, *pool_scale, *w_out, *ln1_g, *ln1_b, *w_mlp1, *b_mlp1, *w_mlp2, *b_mlp2, *ln2_g, *ln2_b;
    float* out; unsigned char* ws;
};

typedef __bf16 v2bf_t __attribute__((ext_vector_type(2)));
typedef float v2f_t __attribute__((ext_vector_type(2)));
__device__ __forceinline__ unsigned pk2(float lo, float hi) { const v2f_t f = {lo, hi}; const v2bf_t b = __builtin_convertvector(f, v2bf_t); return __builtin_bit_cast(unsigned, b); }
__device__ __forceinline__ bf16_t bf1(float v) { return (bf16_t)pk2(v, 0.f); }
__device__ __forceinline__ float bflo(unsigned w) { return __uint_as_float(w << 16); }
__device__ __forceinline__ float bfhi(unsigned w) { return __uint_as_float(w & 0xffff0000u); }
__device__ __forceinline__ float wave_sum(float v) {
#pragma unroll
    for (int o = 1; o < 64; o <<= 1) v += __shfl_xor(v, o);
    return v;
}
__device__ __forceinline__ int opaque_tid() { int t = threadIdx.x; asm volatile("" : "+v"(t)); return t; }
__device__ __forceinline__ int opaque_s(int v) { asm volatile("" : "+s"(v)); return v; }
__device__ __forceinline__ float siluf(float v) { return v / (1.f + __expf(-v)); }
__device__ __forceinline__ float log_sigmoidf(float z) { return fminf(z, 0.f) - log1pf(__expf(-fabsf(z))); }

namespace pg8 {
constexpr int BM = 256, BK = 64, HALF = 128, HTB = HALF * BK * 2, STAGE_BYTES = 8 * HTB, NXCD = 8, WGM = 8;
__host__ __device__ __forceinline__ int lds_byte(int r, int c) { const int st = (r >> 4) * 2 + (c >> 5), rr = r & 15, cc = c & 31, ob = rr * 64 + cc * 2; return st * 1024 + (ob ^ (((ob >> 9) & 1) << 5)); }
__host__ __device__ __forceinline__ void stage_rc(int b, int& R, int& C) { const int st = b / 1024, sb = b % 1024, swz = sb ^ (((sb >> 9) & 1) << 5); R = (st >> 1) * 16 + swz / 64; C = (st & 1) * 32 + (swz % 64) / 2; }
__host__ __device__ __forceinline__ int perm32(int rho) { const int n = rho >> 4, i = rho & 15; return 8 * (i >> 2) + 4 * n + (i & 3); }
struct Unit { int pm, pn, kt0, nkt, part; };
struct Gemm { const bf16_t* A; const bf16_t* Bt; int M, N, K, lda, ldb, a_pn_off; };
struct StaticOrder {
    int nM, nN, nwg, G, c, nt, ks, nsub;
    __device__ __forceinline__ void init(int M, int N, int G_, int c_) { nM = M / BM; nN = N / BM; nwg = nM * nN; G = G_; c = c_; nt = 0; ks = 1; nsub = 0; }
    __device__ __forceinline__ void init_split(int Mlat, int N, int G_, int c_, int ctx_tiles, int ks_) { nM = Mlat / BM; nN = N / BM; nwg = nM * nN; G = G_; c = c_; nt = 0; ks = ks_; nsub = ctx_tiles * nN * ks_; }
    __device__ __forceinline__ Unit next(int i) const {
        Unit u; u.pm = 0; u.pn = 0; u.kt0 = 0; u.nkt = 0; u.part = -1;
        const long L = (long)i * G + c;
        if (L >= nwg) { const int sidx = (int)(L - nwg);
            if (sidx < nsub) { const int tile = sidx / ks; u.part = sidx % ks; u.pm = nM + tile / nN; u.pn = tile % nN; u.nkt = nt / ks; u.kt0 = u.part * u.nkt; }
            return u; }
        int wgid = (int)L; { const int q = nwg / NXCD, r = nwg % NXCD, xcd = wgid % NXCD, off = wgid / NXCD; wgid = (xcd < r ? xcd * (q + 1) : r * (q + 1) + (xcd - r) * q) + off; }
        const int nig = WGM * nN, gid = wgid / nig, fm = gid * WGM, gsz = (nM - fm) < WGM ? (nM - fm) : WGM;
        u.pm = fm + ((wgid % nig) % gsz); u.pn = (wgid % nig) / gsz; u.nkt = nt; return u;
    }
};

template <class Epi>
__device__ __forceinline__ void gemm_phase(LAS unsigned char* lds, const Gemm g, StaticOrder S, const Epi& E) {
    const int tid = opaque_tid(), wid = __builtin_amdgcn_readfirstlane(tid >> 6), lane = tid & 63, wr = wid >> 2, wc = wid & 3, fr = lane & 15, fq = lane >> 4;
    int K_ = g.K; asm volatile("" : "+s"(K_));
    const int K = K_; S.nt = K / BK;
    unsigned voffA[2], voffB[2];
#pragma unroll
    for (int i = 0; i < 2; ++i) { int R, C; stage_rc(tid * 16 + i * 8192, R, C); const int Rb = Epi::PERM ? ((R & ~31) + perm32(R & 31)) : R;
        voffA[i] = (unsigned)(R * g.lda + C) * 2u; voffB[i] = (unsigned)(Rb * g.ldb + C) * 2u; }
    const size_t kstep = (size_t)(BK * 2);
    const size_t hstepA = (size_t)HALF * g.lda * 2, hstepB = (size_t)HALF * g.ldb * 2;
    const size_t tstepA = 2 * hstepA, tstepB = 2 * hstepB;
    const unsigned ldsw = (unsigned)wid * 1024u;
    const int aoff = lds_byte(wr * 64 + fr, fq * 8), boff = lds_byte(wc * 32 + fr, fq * 8);
#define PG8_SA(b, h) (((b) * 2 + (h)) * HTB)
#define PG8_SB(b, h) ((4 + (b) * 2 + (h)) * HTB)
#define PG8_STAGE(bufoff, gbase, voff) do { _Pragma("unroll") for (int _i = 0; _i < 2; ++_i) \
        __builtin_amdgcn_global_load_lds((const unsigned*)((const char*)(gbase) + (voff)[_i]), (LAS unsigned*)(lds + (bufoff) + ldsw + _i * 8192), 16, 0, 0); } while (0)
#define PG8_LDA(dst, b, h) do { _Pragma("unroll") for (int m = 0; m < 4; ++m) _Pragma("unroll") for (int k = 0; k < 2; ++k) dst[m][k] = *(const LAS bf16x8*)(lds + PG8_SA(b, h) + aoff + m * 2048 + k * 1024); } while (0)
#define PG8_LDB(dst, b, h) do { _Pragma("unroll") for (int n = 0; n < 2; ++n) _Pragma("unroll") for (int k = 0; k < 2; ++k) dst[n][k] = *(const LAS bf16x8*)(lds + PG8_SB(b, h) + boff + n * 2048 + k * 1024); } while (0)
#define PG8_MMA(ai, bj, At, Bt) do { __builtin_amdgcn_s_setprio(1); _Pragma("unroll") for (int m = 0; m < 4; ++m) _Pragma("unroll") for (int n = 0; n < 2; ++n) _Pragma("unroll") for (int k = 0; k < 2; ++k) \
        acc[ai][bj][m][n] = __builtin_amdgcn_mfma_f32_16x16x32_bf16(Bt[n][k], At[m][k], acc[ai][bj][m][n], 0, 0, 0); __builtin_amdgcn_s_setprio(0); } while (0)
#define PG8_WAIT_V(n) asm volatile("s_waitcnt vmcnt(" #n ")" ::: "memory")
#define PG8_WAIT_L(n) asm volatile("s_waitcnt lgkmcnt(" #n ")" ::: "memory")
#define PG8_BAR __builtin_amdgcn_s_barrier()
#define PG8_SCHED __builtin_amdgcn_sched_barrier(0)
    Unit cur = S.next(0), nxt; int ui = 0;
    if (cur.nkt == 0) return;
    f32x4 acc[2][2][4][2];
#pragma unroll
    for (int a = 0; a < 2; ++a)
#pragma unroll
        for (int b = 0; b < 2; ++b)
#pragma unroll
            for (int m = 0; m < 4; ++m)
#pragma unroll
                for (int n = 0; n < 2; ++n) acc[a][b][m][n] = (f32x4){0.f, 0.f, 0.f, 0.f};
    bf16x8 At[4][2], B0[2][2], B1[2][2];
    const char* cA = (const char*)g.A + (size_t)cur.pm * tstepA + (size_t)cur.pn * g.a_pn_off + (size_t)cur.kt0 * kstep; const char* cB = (const char*)g.Bt + (size_t)cur.pn * tstepB + (size_t)cur.kt0 * kstep;
    PG8_STAGE(PG8_SB(0, 0), cB, voffB); PG8_STAGE(PG8_SA(0, 0), cA, voffA); PG8_STAGE(PG8_SB(0, 1), cB + hstepB, voffB); PG8_STAGE(PG8_SA(0, 1), cA + hstepA, voffA);
    if (wr == 1) PG8_BAR;
    PG8_WAIT_V(4); PG8_BAR;
    PG8_STAGE(PG8_SB(1, 0), cB + kstep, voffB); PG8_STAGE(PG8_SA(1, 0), cA + kstep, voffA); PG8_STAGE(PG8_SB(1, 1), cB + hstepB + kstep, voffB);
    PG8_WAIT_V(6); PG8_BAR;
    for (;;) {
        nxt = S.next(ui + 1); const bool has_next = nxt.nkt != 0;
        const char* nA = has_next ? (const char*)g.A + (size_t)nxt.pm * tstepA + (size_t)nxt.pn * g.a_pn_off + (size_t)nxt.kt0 * kstep : cA; const char* nB = has_next ? (const char*)g.Bt + (size_t)nxt.pn * tstepB + (size_t)nxt.kt0 * kstep : cB;
        const int ntc = cur.nkt;
        for (int t = 0; t < ntc; t += 2) {
            const bool last = (t == ntc - 2);
            const char* a1 = cA + (size_t)(t + 1) * kstep;
            const char* a2 = last ? nA : cA + (size_t)(t + 2) * kstep; const char* b2 = last ? nB : cB + (size_t)(t + 2) * kstep;
            const char* a3 = a2 + kstep; const char* b3 = b2 + kstep;
            PG8_LDB(B0, 0, 0); PG8_SCHED; PG8_LDA(At, 0, 0); PG8_STAGE(PG8_SA(1, 1), a1 + hstepA, voffA);
            PG8_WAIT_L(8); PG8_BAR; PG8_WAIT_L(0); PG8_MMA(0, 0, At, B0); PG8_BAR; PG8_SCHED;
            PG8_LDB(B1, 0, 1); PG8_STAGE(PG8_SB(0, 0), b2, voffB);
            PG8_BAR; PG8_WAIT_L(0); PG8_MMA(0, 1, At, B1); PG8_BAR;
            PG8_LDA(At, 0, 1); PG8_STAGE(PG8_SA(0, 0), a2, voffA);
            PG8_BAR; PG8_WAIT_L(0); PG8_MMA(1, 0, At, B0); PG8_BAR; PG8_SCHED;
            PG8_STAGE(PG8_SB(0, 1), b2 + hstepB, voffB);
            PG8_WAIT_V(6); PG8_BAR; PG8_MMA(1, 1, At, B1); PG8_BAR;
            PG8_LDB(B0, 1, 0); PG8_SCHED; PG8_LDA(At, 1, 0); PG8_STAGE(PG8_SA(0, 1), a2 + hstepA, voffA);
            PG8_WAIT_L(8); PG8_BAR; PG8_WAIT_L(0); PG8_MMA(0, 0, At, B0); PG8_BAR; PG8_SCHED;
            PG8_LDB(B1, 1, 1); PG8_STAGE(PG8_SB(1, 0), b3, voffB);
            PG8_BAR; PG8_WAIT_L(0); PG8_MMA(0, 1, At, B1); PG8_BAR;
            PG8_LDA(At, 1, 1); PG8_STAGE(PG8_SA(1, 0), a3, voffA);
            PG8_BAR; PG8_WAIT_L(0); PG8_MMA(1, 0, At, B0); PG8_BAR; PG8_SCHED;
            PG8_STAGE(PG8_SB(1, 1), b3 + hstepB, voffB);
            PG8_WAIT_V(6); PG8_BAR; PG8_MMA(1, 1, At, B1); PG8_BAR;
        }
        E(acc, cur, wr, wc, fr, fq);
        if (!has_next) break;
#pragma unroll
        for (int a = 0; a < 2; ++a)
#pragma unroll
            for (int b = 0; b < 2; ++b)
#pragma unroll
                for (int m = 0; m < 4; ++m)
#pragma unroll
                    for (int n = 0; n < 2; ++n) acc[a][b][m][n] = (f32x4){0.f, 0.f, 0.f, 0.f};
        cur = nxt; cA = nA; cB = nB; ++ui;
    }
    PG8_WAIT_V(0);
    if (wr == 0) PG8_BAR;
    PG8_BAR;
#undef PG8_SA
#undef PG8_SB
#undef PG8_STAGE
#undef PG8_LDA
#undef PG8_LDB
#undef PG8_MMA
#undef PG8_WAIT_V
#undef PG8_WAIT_L
#undef PG8_BAR
#undef PG8_SCHED
}
}
using pg8::Unit;

typedef __amdgpu_buffer_rsrc_t wsrc_t;
__device__ __forceinline__ wsrc_t ws_rsrc(unsigned char* ws) { return __builtin_amdgcn_make_buffer_rsrc(ws, (short)0, 0x7ffffff0, 0x00020000); }
__device__ __forceinline__ void wt16(const wsrc_t& rs, const unsigned char* ws, const void* p, u32x4 v) { __builtin_amdgcn_raw_buffer_store_b128(v, rs, (unsigned)((const unsigned char*)p - ws), 0, 16); }
struct EpiIn {
    static constexpr bool PERM = true;
    bf16_t *pk, *vtl, *vtc, *pq, *pg, *pu; float* lr; wsrc_t rs; const unsigned char* ws0;
    __device__ __forceinline__ void operator()(const f32x4 (&acc)[2][2][4][2], const Unit& u, int wr, int wc, int fr, int fq) const {
        const int row0 = u.pm * 256 + wr * 64 + fr;
        if (u.pn >= 2 && u.pn < 6) {
            const int cb = (u.pn - 2) * 256 + wc * 32 + 8 * fq;
            bf16_t* vb; int tl, t0;
            if (u.pm < 64) { vb = vtl + (size_t)(u.pm >> 4) * 1024 * T; tl = T; t0 = (u.pm & 15) * 256; } else { vb = vtc + (size_t)(u.pm - 64) * 1024 * CTXL; tl = CTXL; t0 = 0; }
            t0 += wr * 64 + fr;
#pragma unroll
            for (int ai = 0; ai < 2; ++ai)
#pragma unroll
                for (int m = 0; m < 4; ++m) { bf16_t* tp = vb + t0 + ai * 128 + m * 16;
#pragma unroll
                    for (int bj = 0; bj < 2; ++bj)
#pragma unroll
                        for (int n = 0; n < 2; ++n) { const f32x4 v = acc[ai][bj][m][n]; const unsigned w0 = pk2(v[0], v[1]), w1 = pk2(v[2], v[3]); const size_t c = (size_t)(cb + bj * 128 + 4 * n) * tl;
                            tp[c] = (bf16_t)w0; tp[c + tl] = (bf16_t)(w0 >> 16); tp[c + 2 * (size_t)tl] = (bf16_t)w1; tp[c + 3 * (size_t)tl] = (bf16_t)(w1 >> 16); } }
        } else if (u.pn < 16) {
            bf16_t* base; int ld, colt;
            if (u.pn < 2) { base = pk; ld = 512; colt = u.pn * 256; }
            else if (u.pn < 8) { base = pq; ld = 512; colt = (u.pn - 6) * 256; }
            else if (u.pn < 12) { base = pg; ld = 1024; colt = (u.pn - 8) * 256; }
            else { base = pu; ld = 1024; colt = (u.pn - 12) * 256; }
            const int col0 = colt + wc * 32 + 8 * fq;
#pragma unroll
            for (int ai = 0; ai < 2; ++ai)
#pragma unroll
                for (int m = 0; m < 4; ++m) { bf16_t* rowp = base + (size_t)(row0 + ai * 128 + m * 16) * ld + col0;
#pragma unroll
                    for (int bj = 0; bj < 2; ++bj) { const f32x4 v0 = acc[ai][bj][m][0], v1 = acc[ai][bj][m][1];
                        u32x4 w; w.x = pk2(v0[0], v0[1]); w.y = pk2(v0[2], v0[3]); w.z = pk2(v1[0], v1[1]); w.w = pk2(v1[2], v1[3]);
                        wt16(rs, ws0, rowp + bj * 128, w); } }
        } else if (wc == 0) {
#pragma unroll
            for (int ai = 0; ai < 2; ++ai)
#pragma unroll
                for (int m = 0; m < 4; ++m) { float* rowp = lr + (size_t)(row0 + ai * 128 + m * 16) * 32 + 8 * fq;
                    *(f32x4*)(rowp) = acc[ai][0][m][0]; *(f32x4*)(rowp + 4) = acc[ai][0][m][1]; }
        }
    }
};
struct EpiPool {
    static constexpr bool PERM = true;
    bf16_t* mixed; const float* scale; wsrc_t rs; const unsigned char* ws0;
    __device__ __forceinline__ void operator()(const f32x4 (&acc)[2][2][4][2], const Unit& u, int wr, int wc, int fr, int fq) const {
        const int row0 = u.pm * 256 + wr * 64 + fr, col0 = u.pn * 256 + wc * 32 + 8 * fq;
        f32x4 sv[2][2];
#pragma unroll
        for (int bj = 0; bj < 2; ++bj)
#pragma unroll
            for (int n = 0; n < 2; ++n) sv[bj][n] = scale ? *(const f32x4*)(scale + col0 + bj * 128 + 4 * n) : (f32x4){1.f, 1.f, 1.f, 1.f};
#pragma unroll
        for (int ai = 0; ai < 2; ++ai)
#pragma unroll
            for (int m = 0; m < 4; ++m) { bf16_t* rowp = mixed + (size_t)(row0 + ai * 128 + m * 16) * D + 1024 + col0;
#pragma unroll
                for (int bj = 0; bj < 2; ++bj) { const f32x4 v0 = acc[ai][bj][m][0] * sv[bj][0], v1 = acc[ai][bj][m][1] * sv[bj][1];
                    u32x4 w; w.x = pk2(v0[0], v0[1]); w.y = pk2(v0[2], v0[3]); w.z = pk2(v1[0], v1[1]); w.w = pk2(v1[2], v1[3]);
                    wt16(rs, ws0, rowp + bj * 128, w); } }
    }
};
struct EpiMlp1 {
    static constexpr bool PERM = true;
    bf16_t* a1; const float* bias; wsrc_t rs; const unsigned char* ws0;
    __device__ __forceinline__ void operator()(const f32x4 (&acc)[2][2][4][2], const Unit& u, int wr, int wc, int fr, int fq) const {
        const int row0 = u.pm * 256 + wr * 64 + fr, col0 = u.pn * 256 + wc * 32 + 8 * fq;
        f32x4 bv[2][2];
#pragma unroll
        for (int bj = 0; bj < 2; ++bj)
#pragma unroll
            for (int n = 0; n < 2; ++n) bv[bj][n] = *(const f32x4*)(bias + col0 + bj * 128 + 4 * n);
#pragma unroll
        for (int ai = 0; ai < 2; ++ai)
#pragma unroll
            for (int m = 0; m < 4; ++m) { bf16_t* rowp = a1 + (size_t)(row0 + ai * 128 + m * 16) * DFF + col0;
#pragma unroll
                for (int bj = 0; bj < 2; ++bj) { f32x4 v0 = acc[ai][bj][m][0] + bv[bj][0], v1 = acc[ai][bj][m][1] + bv[bj][1];
#pragma unroll
                    for (int j = 0; j < 4; ++j) { const float a = fmaxf(v0[j], 0.f), b = fmaxf(v1[j], 0.f); v0[j] = a * a; v1[j] = b * b; }
                    u32x4 w; w.x = pk2(v0[0], v0[1]); w.y = pk2(v0[2], v0[3]); w.z = pk2(v1[0], v1[1]); w.w = pk2(v1[2], v1[3]);
                    wt16(rs, ws0, rowp + bj * 128, w); } }
    }
};
struct EpiDelta {
    static constexpr bool PERM = true;
    bf16_t* delta; const float* gate  ; const float* bias; float* part  ; wsrc_t rs; const unsigned char* ws0;
    __device__ __forceinline__ void operator()(const f32x4 (&acc)[2][2][4][2], const Unit& u, int wr, int wc, int fr, int fq) const {
        const int row0 = u.pm * 256 + wr * 64 + fr, col0 = u.pn * 256 + wc * 32 + 8 * fq;
        if (u.part >= 0) {
            float* pp = part + ((size_t)u.part * ROWS_CTX + (row0 - ROWS_LAT)) * D + col0;
#pragma unroll
            for (int ai = 0; ai < 2; ++ai)
#pragma unroll
                for (int m = 0; m < 4; ++m)
#pragma unroll
                    for (int bj = 0; bj < 2; ++bj)
#pragma unroll
                        for (int n = 0; n < 2; ++n) *(f32x4*)(pp + (size_t)(ai * 128 + m * 16) * D + bj * 128 + 4 * n) = acc[ai][bj][m][n];
            return;
        }
        const int mr = u.pm < 64 ? (u.pm >> 4) : 4;
        const float* gp = gate + (size_t)mr * 6 * D + col0;
        f32x4 gv[2][2], bv[2][2];
#pragma unroll
        for (int bj = 0; bj < 2; ++bj)
#pragma unroll
            for (int n = 0; n < 2; ++n) { gv[bj][n] = *(const f32x4*)(gp + bj * 128 + 4 * n); bv[bj][n] = bias ? *(const f32x4*)(bias + col0 + bj * 128 + 4 * n) : (f32x4){0.f, 0.f, 0.f, 0.f}; }
#pragma unroll
        for (int ai = 0; ai < 2; ++ai)
#pragma unroll
            for (int m = 0; m < 4; ++m) { bf16_t* rowp = delta + (size_t)(row0 + ai * 128 + m * 16) * D + col0;
#pragma unroll
                for (int bj = 0; bj < 2; ++bj) { const f32x4 v0 = gv[bj][0] * (acc[ai][bj][m][0] + bv[bj][0]), v1 = gv[bj][1] * (acc[ai][bj][m][1] + bv[bj][1]);
                    u32x4 w; w.x = pk2(v0[0], v0[1]); w.y = pk2(v0[2], v0[3]); w.z = pk2(v1[0], v1[1]); w.w = pk2(v1[2], v1[3]);
                    wt16(rs, ws0, rowp + bj * 128, w); } }
    }
};

__device__ __forceinline__ void modp_task(const Params& p, int l, int task, LAS float* sl) {
    const int tid = opaque_tid();
    const int s = task / 6, nb = task % 6;
    const int k0 = s * 64, n0 = nb * 2048 + tid * 4;
    if (tid < 320) { const int r = tid >> 6, kk = tid & 63; const float cv = r < 4 ? p.c[r * D + k0 + kk] : p.c_ctx[k0 + kk]; sl[tid] = siluf(cv); }
    __syncthreads();
    f32x4 acc[5];
#pragma unroll
    for (int r = 0; r < 5; ++r) acc[r] = (f32x4){0.f, 0.f, 0.f, 0.f};
    const float* wp = p.w_ada + ((size_t)l * D + k0) * 12288 + n0;
#pragma unroll 8
    for (int kk = 0; kk < 64; ++kk) { const f32x4 w = __builtin_nontemporal_load((const f32x4*)(wp + (size_t)kk * 12288));
#pragma unroll
        for (int r = 0; r < 5; ++r) acc[r] += sl[r * 64 + kk] * w; }
    float* mp = (float*)(p.ws + OFF_MODP) + ((size_t)(s * 2 + l) * 5) * 12288 + n0;
#pragma unroll
    for (int r = 0; r < 5; ++r) *(f32x4*)(mp + (size_t)r * 12288) = acc[r];
    __syncthreads();
}
constexpr int CVT_ITEMS = 4352 + 2048 + 8192 + 8192 + 128;
constexpr int CVT_SPLIT = 4352 + 5500;
__device__ __forceinline__ void convert_item(const Params& p, int l, int it, LAS float* scr, int lane) {
    const float* src; bf16_t* dst; int K, ld, nbn, mode = 0, pgi = 0;
    bf16_t* wb = (bf16_t*)(p.ws + OFF_W);
    if (it < 4352) { src = p.w_in + (size_t)l * D * 4128; ld = 4128; K = 2048; nbn = 136; dst = wb; mode = 1; }
    else if ((it -= 4352) < 2048) { src = p.w_out + (size_t)l * D * D; ld = 2048; K = 2048; nbn = 64; dst = wb + NW_IN; }
    else if ((it -= 2048) < 8192) { src = p.w_mlp1 + (size_t)l * D * DFF; ld = 8192; K = 2048; nbn = 256; dst = wb + NW_IN + NW_OUT; }
    else if ((it -= 8192) < 8192) { src = p.w_mlp2 + (size_t)l * DFF * D; ld = 2048; K = 8192; nbn = 64; dst = wb + NW_IN + NW_OUT + NW_1; }
    else { it -= 8192; const int gi = it >> 5; it &= 31; src = p.w_pool + ((size_t)l * 4 + gi) * 65536; ld = 256; K = 256; nbn = 8; dst = wb + NW_IN + NW_OUT + NW_1 + NW_2 + (size_t)gi * 65536; mode = 2; pgi = gi; }
    const int kb = it / nbn, nb = it % nbn, k0 = 64 * kb, n0 = 32 * nb;
    if (mode == 2) {
        const float sc_ = p.pool_scale[l * 1024 + pgi * 256 + n0 + (lane & 31)];
#pragma unroll 8
        for (int i = 0; i < 32; ++i) { const int kk = 2 * i + (lane >> 5); dst[(size_t)(k0 + kk) * 256 + n0 + (lane & 31)] = bf1(src[(size_t)(k0 + kk) * 256 + n0 + (lane & 31)] * sc_); }
        return;
    }
    int ns = n0;
    if (mode == 1) ns = n0 < 1536 ? n0 : (n0 < 4096 ? n0 + 32 : (n0 < 4128 ? 1536 + (n0 - 4096) : -1));
    if (ns >= 0) {
        const int kr = lane >> 3, nq = lane & 7; f32x4 t[8];
#pragma unroll
        for (int i = 0; i < 8; ++i) t[i] = __builtin_nontemporal_load((const f32x4*)(src + (size_t)(k0 + 8 * i + kr) * ld + ns + 4 * nq));
#pragma unroll
        for (int i = 0; i < 8; ++i) { LAS float* q = scr + (8 * i + kr) * 33 + 4 * nq; q[0] = t[i][0]; q[1] = t[i][1]; q[2] = t[i][2]; q[3] = t[i][3]; }
    } else {
#pragma unroll 8
        for (int i = 0; i < 32; ++i) { const int kk = 2 * i + (lane >> 5); scr[kk * 33 + (lane & 31)] = 0.f; }
    }
    asm volatile("s_waitcnt lgkmcnt(0)" ::: "memory");
    const int c = lane & 7;
#pragma unroll
    for (int j = 0; j < 4; ++j) { const int n = (lane >> 3) + 8 * j; const LAS float* s = scr + (8 * c) * 33 + n;
        u32x4 o; o.x = pk2(s[0 * 33], s[1 * 33]); o.y = pk2(s[2 * 33], s[3 * 33]); o.z = pk2(s[4 * 33], s[5 * 33]); o.w = pk2(s[6 * 33], s[7 * 33]);
        *(u32x4*)(dst + (size_t)(n0 + n) * K + k0 + 8 * c) = o; }
    asm volatile("s_waitcnt lgkmcnt(0)" ::: "memory");
}
__device__ __forceinline__ void convert_phase(const Params& p, int l, LAS float* ldsf, int it_lo, int it_hi, int wg0, int nwg) {
    const int tid = opaque_tid(), lane = tid & 63, wave = tid >> 6;
    LAS float* scr = ldsf + wave * (64 * 33);
    for (int it = it_lo + ((int)blockIdx.x - wg0) * 8 + wave; it < it_hi; it += nwg * 8) convert_item(p, l, it, scr, lane);
}
__device__ __forceinline__ void ln_phase(int nrows, const float* src_lat, const float* src_ctx, const float* g, const float* b, float* dst_lat, float* dst_ctx,
                                         const float* modl  , int jsh, int jsc, bf16_t* hout,
                                         const bf16_t* delta = nullptr, const float* part = nullptr, const float* pgate = nullptr, const float* pbias = nullptr) {
    const int tid_ = opaque_tid(), lane = tid_ & 63, wave = tid_ >> 6;
    const int stride = gridDim.x * 8;
    int r = blockIdx.x * 8 + wave;
    f32x4 nv[8]; u32x4 nd[4];
#define LN_C(i) ((lane + 64 * ((i) >> 1)) * 8 + ((i) & 1) * 4)
#define LN_LOAD(rr) do { const float* src_ = (rr) < ROWS_LAT ? src_lat + (size_t)(rr) * D : src_ctx + (size_t)((rr) - ROWS_LAT) * D; \
        _Pragma("unroll") for (int i = 0; i < 8; ++i) nv[i] = *(const f32x4*)(src_ + LN_C(i)); \
        if (delta) { const bf16_t* dp_ = delta + (size_t)(rr) * D; _Pragma("unroll") for (int i = 0; i < 4; ++i) nd[i] = *(const u32x4*)(dp_ + (lane + 64 * i) * 8); } } while (0)
#pragma unroll
    for (int i = 0; i < 4; ++i) nd[i] = (u32x4){0u, 0u, 0u, 0u};
    if (r < nrows) LN_LOAD(r);
    for (; r < nrows; r += stride) {
        f32x4 v[8]; u32x4 dl[4];
#pragma unroll
        for (int i = 0; i < 8; ++i) v[i] = nv[i];
#pragma unroll
        for (int i = 0; i < 4; ++i) dl[i] = nd[i];
        const int rn = r + stride;
        if (rn < nrows) LN_LOAD(rn);
        if (delta && !(part && r >= ROWS_LAT)) {
#pragma unroll
            for (int i = 0; i < 4; ++i) { v[2 * i] = ALPHA * v[2 * i] + (f32x4){bflo(dl[i].x), bfhi(dl[i].x), bflo(dl[i].y), bfhi(dl[i].y)}; v[2 * i + 1] = ALPHA * v[2 * i + 1] + (f32x4){bflo(dl[i].z), bfhi(dl[i].z), bflo(dl[i].w), bfhi(dl[i].w)}; }
        }
        if (part && r >= ROWS_LAT) {
            f32x4 a[8];
#pragma unroll
            for (int i = 0; i < 8; ++i) a[i] = pbias ? *(const f32x4*)(pbias + LN_C(i)) : (f32x4){0.f, 0.f, 0.f, 0.f};
#pragma unroll 1
            for (int k = 0; k < 8; ++k) { const float* pp = part + ((size_t)k * ROWS_CTX + (r - ROWS_LAT)) * D;
#pragma unroll
                for (int i = 0; i < 8; ++i) a[i] += *(const f32x4*)(pp + LN_C(i)); }
#pragma unroll
            for (int i = 0; i < 8; ++i) v[i] = ALPHA * v[i] + *(const f32x4*)(pgate + LN_C(i)) * a[i];
        }
        if (g) {
            float s = 0.f;
#pragma unroll
            for (int i = 0; i < 8; ++i) s += (v[i][0] + v[i][1]) + (v[i][2] + v[i][3]);
            const float mean = wave_sum(s) * (1.f / D); float q = 0.f;
#pragma unroll
            for (int i = 0; i < 8; ++i) { v[i] = v[i] - mean; q += (v[i][0] * v[i][0] + v[i][1] * v[i][1]) + (v[i][2] * v[i][2] + v[i][3] * v[i][3]); }
            const float rstd = 1.f / sqrtf(wave_sum(q) * (1.f / D) + 1e-6f);
            float* dst = r < ROWS_LAT ? (dst_lat ? dst_lat + (size_t)r * D : nullptr) : (dst_ctx ? dst_ctx + (size_t)(r - ROWS_LAT) * D : nullptr);
#pragma unroll
            for (int i = 0; i < 8; ++i) { const int c = LN_C(i); v[i] = v[i] * rstd * *(const f32x4*)(g + c) + *(const f32x4*)(b + c); if (dst) *(f32x4*)(dst + c) = v[i]; }
        }
        if (hout) {
            const int mr = r < ROWS_LAT ? (r >> 12) : 4;
            const float* sh = modl + ((size_t)mr * 6 + jsh) * D; const float* sc = modl + ((size_t)mr * 6 + jsc) * D;
            float s = 0.f;
#pragma unroll
            for (int i = 0; i < 8; ++i) s += (v[i][0] + v[i][1]) + (v[i][2] + v[i][3]);
            const float mean = wave_sum(s) * (1.f / D); float q = 0.f;
#pragma unroll
            for (int i = 0; i < 8; ++i) { v[i] = v[i] - mean; q += (v[i][0] * v[i][0] + v[i][1] * v[i][1]) + (v[i][2] * v[i][2] + v[i][3] * v[i][3]); }
            const float rstd = 1.f / sqrtf(wave_sum(q) * (1.f / D) + 1e-6f);
            bf16_t* hp = hout + (size_t)r * D;
#pragma unroll
            for (int i = 0; i < 4; ++i) { const int c = (lane + 64 * i) * 8;
                const f32x4 o0 = v[2 * i] * rstd * (1.f + *(const f32x4*)(sc + c)) + *(const f32x4*)(sh + c), o1 = v[2 * i + 1] * rstd * (1.f + *(const f32x4*)(sc + c + 4)) + *(const f32x4*)(sh + c + 4);
                u32x4 w; w.x = pk2(o0[0], o0[1]); w.y = pk2(o0[2], o0[3]); w.z = pk2(o1[0], o1[1]); w.w = pk2(o1[2], o1[3]); *(u32x4*)(hp + c) = w; }
        }
    }
#undef LN_LOAD
#undef LN_C
}
__device__ __forceinline__ void gla_prep(const Params& p, int l, LAS unsigned char* lds) {
    const int tid = opaque_tid(), lane = tid & 63, wave = __builtin_amdgcn_readfirstlane(tid >> 6), fr = lane & 15, fq = lane >> 4;
    LAS bf16_t* qts = (LAS bf16_t*)lds;
    LAS bf16_t* kts = (LAS bf16_t*)(lds + 17408);
    LAS bf16_t* khs = (LAS bf16_t*)(lds + 34816);
    LAS bf16_t* ps = (LAS bf16_t*)(lds + 53248);
    LAS float* lrs = (LAS float*)(lds + 62464);
    LAS float* gts = (LAS float*)(lds + 66560);
    unsigned char* C = p.ws + OFF_C;
    const bf16_t* pq = (const bf16_t*)(C + C_PQ); const bf16_t* pk = (const bf16_t*)(C + C_PK); const float* lr = (const float*)(C + C_LR);
    const int d = tid & 127, mg = tid >> 7;
    f32x4 nlr = {0.f, 0.f, 0.f, 0.f}; float nwu[16], nbg = 0.f; unsigned short nq[16], nk[16];
#define PREP_LOAD(item_) do { const int chain_ = (item_) / 68, mc_ = (item_) % 68, b_ = chain_ >> 3, h_ = (chain_ >> 1) & 3, dir_ = chain_ & 1; \
        const int rb_ = mc_ < 4 ? ROWS_LAT + b_ * CTXL + mc_ * 64 : b_ * T + (mc_ - 4) * 64; \
        if (tid < 256) nlr = *(const f32x4*)(lr + (size_t)(rb_ + (tid >> 2)) * 32 + dir_ * 16 + (tid & 3) * 4); \
        _Pragma("unroll") for (int r = 0; r < 16; ++r) nwu[r] = p.w_gate_up[((size_t)(l * 2 + dir_) * 16 + r) * 512 + h_ * 128 + d]; \
        nbg = p.b_gate[(size_t)(l * 2 + dir_) * 512 + h_ * 128 + d]; \
        _Pragma("unroll") for (int j = 0; j < 16; ++j) { nq[j] = pq[(size_t)(rb_ + mg * 16 + j) * 512 + h_ * 128 + d]; nk[j] = pk[(size_t)(rb_ + mg * 16 + j) * 512 + h_ * 128 + d]; } } while (0)
    if ((int)blockIdx.x < 2176) PREP_LOAD((int)blockIdx.x);
    for (int item = blockIdx.x; item < 2176; item += gridDim.x) {
        const int chain = item / 68, mc = item % 68, dir = chain & 1;
        if (tid < 256) *(LAS f32x4*)(lrs + (tid >> 2) * 16 + (tid & 3) * 4) = nlr;
        float wu[16]; unsigned short cq[16], ck[16];
#pragma unroll
        for (int r = 0; r < 16; ++r) { wu[r] = nwu[r]; cq[r] = nq[r]; ck[r] = nk[r]; }
        const float bg = nbg;
        __syncthreads();
        if (item + (int)gridDim.x < 2176) PREP_LOAD(item + (int)gridDim.x);
        float la[16];
#pragma unroll
        for (int j = 0; j < 16; ++j) { const int m = mg * 16 + j; float z = bg;
#pragma unroll
            for (int r4 = 0; r4 < 4; ++r4) { const f32x4 x = *(const LAS f32x4*)(lrs + m * 16 + r4 * 4); z += x[0] * wu[r4 * 4] + x[1] * wu[r4 * 4 + 1] + x[2] * wu[r4 * 4 + 2] + x[3] * wu[r4 * 4 + 3]; }
            la[j] = (fminf(z, 0.f) - __logf(1.f + __expf(-fabsf(z)))) * (1.f / 16.f); }
        if (dir == 0) {
#pragma unroll
            for (int j = 1; j < 16; ++j) la[j] += la[j - 1];
        } else {
#pragma unroll
            for (int j = 14; j >= 0; --j) la[j] += la[j + 1];
        }
        gts[mg * 128 + d] = dir == 0 ? la[15] : la[0];
        __syncthreads();
        const float g0 = gts[d], g1 = gts[128 + d], g2 = gts[256 + d], g3 = gts[384 + d];
        const float total = (g0 + g1) + (g2 + g3);
        float off = 0.f;
        if (dir == 0) { if (mg > 0) off += g0; if (mg > 1) off += g1; if (mg > 2) off += g2; } else { if (mg < 3) off += g3; if (mg < 2) off += g2; if (mg < 1) off += g1; }
        float kh[16];
#pragma unroll
        for (int j = 0; j < 16; ++j) { const int m = mg * 16 + j; const float cum = fmaxf(la[j] + off, -80.f);
            const float qv = __uint_as_float(((unsigned)cq[j]) << 16), kv = __uint_as_float(((unsigned)ck[j]) << 16);
            qts[m * 136 + d] = bf1(qv * QSCALE * __expf(cum)); kts[m * 136 + d] = bf1(kv * __expf(-cum)); kh[j] = kv * __expf(total - cum); }
        { u32x4 w0, w1;
          w0.x = pk2(kh[0], kh[1]); w0.y = pk2(kh[2], kh[3]); w0.z = pk2(kh[4], kh[5]); w0.w = pk2(kh[6], kh[7]);
          w1.x = pk2(kh[8], kh[9]); w1.y = pk2(kh[10], kh[11]); w1.z = pk2(kh[12], kh[13]); w1.w = pk2(kh[14], kh[15]);
          *(LAS u32x4*)(khs + d * 72 + mg * 16) = w0; *(LAS u32x4*)(khs + d * 72 + mg * 16 + 8) = w1; }
        if (mg == 0) ((float*)(C + C_E))[(size_t)item * 128 + d] = __expf(total);
        __syncthreads();
#pragma unroll
        for (int tt = 0; tt < 2; ++tt) { const int tile = wave * 2 + tt, it = tile >> 2, jt = tile & 3; f32x4 acc = {0.f, 0.f, 0.f, 0.f};
#pragma unroll
            for (int ks = 0; ks < 4; ++ks) { const bf16x8 a = *(const LAS bf16x8*)(qts + (it * 16 + fr) * 136 + ks * 32 + fq * 8), bb = *(const LAS bf16x8*)(kts + (jt * 16 + fr) * 136 + ks * 32 + fq * 8);
                acc = __builtin_amdgcn_mfma_f32_16x16x32_bf16(a, bb, acc, 0, 0, 0); }
#pragma unroll
            for (int jj = 0; jj < 4; ++jj) { const int i = it * 16 + fq * 4 + jj, jc = jt * 16 + fr; const bool keep = dir == 0 ? (jc <= i) : (jc >= i); ps[i * 72 + jc] = bf1(keep ? acc[jj] : 0.f); } }
        __syncthreads();
        bf16_t* qo = (bf16_t*)(C + C_QT) + (size_t)item * 8192; bf16_t* ko = (bf16_t*)(C + C_KHT) + (size_t)item * 8192; bf16_t* po = (bf16_t*)(C + C_P) + (size_t)item * 4096;
#pragma unroll
        for (int k = 0; k < 2; ++k) { const int q = tid + 512 * k; *(u32x4*)(qo + (q >> 4) * 128 + (q & 15) * 8) = *(const LAS u32x4*)(qts + (q >> 4) * 136 + (q & 15) * 8);
            *(u32x4*)(ko + (q >> 3) * 64 + (q & 7) * 8) = *(const LAS u32x4*)(khs + (q >> 3) * 72 + (q & 7) * 8); }
        *(u32x4*)(po + (tid >> 3) * 64 + (tid & 7) * 8) = *(const LAS u32x4*)(ps + (tid >> 3) * 72 + (tid & 7) * 8);
        __syncthreads();
    }
#undef PREP_LOAD
}
constexpr int CH_BUF = 54784, CH_KH = 17408, CH_P = 35840, CH_V = 45056, CH_E = 54272, CH_ST = 2 * CH_BUF;
__device__ __forceinline__ void gla_chain(const Params& p, LAS unsigned char* lds) {
    if (blockIdx.x >= 128) return;
    const int tid = opaque_tid(), lane = tid & 63, wave = __builtin_amdgcn_readfirstlane(tid >> 6), fr = lane & 15, fq = lane >> 4;
    const int chain = blockIdx.x & 31, vg = blockIdx.x >> 5, b = chain >> 3, h = (chain >> 1) & 3, dir = chain & 1;
    unsigned char* C = p.ws + OFF_C;
    const bf16_t* QTg = (const bf16_t*)(C + C_QT) + (size_t)chain * 68 * 8192; const bf16_t* KHg = (const bf16_t*)(C + C_KHT) + (size_t)chain * 68 * 8192;
    const bf16_t* Pg = (const bf16_t*)(C + C_P) + (size_t)chain * 68 * 4096; const float* Eg = (const float*)(C + C_E) + (size_t)chain * 68 * 128;
    const bf16_t* vtl = (const bf16_t*)(C + C_VTL) + ((size_t)b * 1024 + h * 256 + vg * 64 + (tid >> 3)) * T + (tid & 7) * 8;
    const bf16_t* vtc = (const bf16_t*)(C + C_VTC) + ((size_t)b * 1024 + h * 256 + vg * 64 + (tid >> 3)) * CTXL + (tid & 7) * 8;
    bf16_t* Og = (bf16_t*)(C + (dir ? C_OB : C_OF)) + h * 256 + vg * 64 + (wave & 3) * 16 + fq * 4;
    LAS unsigned char* st = lds + CH_ST + (wave & 3) * 4352;
    u32x4 ra0, ra1, ra2, ra3, ra4, ra5, rb0, rb1, rb2, rb3, rb4, rb5; f32x4 rae = {0.f, 0.f, 0.f, 0.f}, rbe = {0.f, 0.f, 0.f, 0.f};
#define CH_ISSUE_(ci, r0, r1, r2, r3, r4, r5, re) do { const int ci_ = (ci) < 68 ? (ci) : 67; const int mc_ = dir == 0 ? ci_ : (ci_ < 4 ? 3 - ci_ : 71 - ci_); \
        r0 = *(const u32x4*)(QTg + (size_t)mc_ * 8192 + (tid >> 4) * 128 + (tid & 15) * 8); r1 = *(const u32x4*)(QTg + (size_t)mc_ * 8192 + ((tid >> 4) + 32) * 128 + (tid & 15) * 8); \
        r2 = *(const u32x4*)(KHg + (size_t)mc_ * 8192 + (tid >> 3) * 64 + (tid & 7) * 8); r3 = *(const u32x4*)(KHg + (size_t)mc_ * 8192 + ((tid >> 3) + 64) * 64 + (tid & 7) * 8); \
        r4 = *(const u32x4*)(Pg + (size_t)mc_ * 4096 + (tid >> 3) * 64 + (tid & 7) * 8); \
        r5 = mc_ < 4 ? *(const u32x4*)(vtc + mc_ * 64) : *(const u32x4*)(vtl + (mc_ - 4) * 64); \
        re = *(const f32x4*)(Eg + (size_t)mc_ * 128 + (tid & 31) * 4); } while (0)
#define CH_WRITE_(buf, r0, r1, r2, r3, r4, r5, re) do { LAS unsigned char* b_ = lds + (buf) * CH_BUF; \
        *(LAS u32x4*)(b_ + (tid >> 4) * 272 + (tid & 15) * 16) = r0; *(LAS u32x4*)(b_ + ((tid >> 4) + 32) * 272 + (tid & 15) * 16) = r1; \
        *(LAS u32x4*)(b_ + CH_KH + (tid >> 3) * 144 + (tid & 7) * 16) = r2; *(LAS u32x4*)(b_ + CH_KH + ((tid >> 3) + 64) * 144 + (tid & 7) * 16) = r3; \
        *(LAS u32x4*)(b_ + CH_P + (tid >> 3) * 144 + (tid & 7) * 16) = r4; *(LAS u32x4*)(b_ + CH_V + (tid >> 3) * 144 + (tid & 7) * 16) = r5; \
        if (tid < 32) *(LAS f32x4*)(b_ + CH_E + tid * 16) = re; } while (0)
#define SET_A ra0, ra1, ra2, ra3, ra4, ra5, rae
#define SET_B rb0, rb1, rb2, rb3, rb4, rb5, rbe
#define CH_ISSUE(ci, set) CH_ISSUE_X(ci, set)
#define CH_ISSUE_X(ci, ...) CH_ISSUE_(ci, __VA_ARGS__)
#define CH_WRITE(buf, set) CH_WRITE_X(buf, set)
#define CH_WRITE_X(buf, ...) CH_WRITE_(buf, __VA_ARGS__)
    CH_ISSUE(0, SET_A); CH_WRITE(0, SET_A); CH_ISSUE(1, SET_B);
    f32x4 S[8];
#pragma unroll
    for (int dt = 0; dt < 8; ++dt) S[dt] = (f32x4){0.f, 0.f, 0.f, 0.f};
    if (wave < 4) {
#pragma unroll
        for (int dt = 0; dt < 8; ++dt) *(LAS u32x2*)(st + fr * 272 + (dt * 16 + fq * 4) * 2) = (u32x2){0u, 0u};
    }
    __syncthreads();
    auto step = [&](const int ci, LAS unsigned char* cur) {
        const int w4 = wave & 3;
        bf16x8 a_v[2];
#pragma unroll
        for (int ks = 0; ks < 2; ++ks) a_v[ks] = *(const LAS bf16x8*)(cur + CH_V + (w4 * 16 + fr) * 144 + ks * 64 + fq * 16);
        if (wave >= 4) {
            const int mc = dir == 0 ? ci : (ci < 4 ? 3 - ci : 71 - ci);
            const int rb = mc < 4 ? ROWS_LAT + b * CTXL + mc * 64 : b * T + (mc - 4) * 64;
            const LAS unsigned char* sti = st + (ci & 1) * (4 * 4352);
            bf16x8 a_st[4];
#pragma unroll
            for (int ks = 0; ks < 4; ++ks) a_st[ks] = *(const LAS bf16x8*)(sti + fr * 272 + ks * 64 + fq * 16);
#pragma unroll
            for (int ih = 0; ih < 2; ++ih) {
                bf16x8 bq[2][4], bp[2][2]; f32x4 o[2];
#pragma unroll
                for (int i2 = 0; i2 < 2; ++i2) { const int it = ih * 2 + i2; o[i2] = (f32x4){0.f, 0.f, 0.f, 0.f};
#pragma unroll
                    for (int ks = 0; ks < 4; ++ks) bq[i2][ks] = *(const LAS bf16x8*)(cur + (it * 16 + fr) * 272 + ks * 64 + fq * 16);
#pragma unroll
                    for (int ks = 0; ks < 2; ++ks) bp[i2][ks] = *(const LAS bf16x8*)(cur + CH_P + (it * 16 + fr) * 144 + ks * 64 + fq * 16); }
#pragma unroll
                for (int ks = 0; ks < 4; ++ks)
#pragma unroll
                    for (int i2 = 0; i2 < 2; ++i2) o[i2] = __builtin_amdgcn_mfma_f32_16x16x32_bf16(a_st[ks], bq[i2][ks], o[i2], 0, 0, 0);
#pragma unroll
                for (int ks = 0; ks < 2; ++ks)
#pragma unroll
                    for (int i2 = 0; i2 < 2; ++i2) o[i2] = __builtin_amdgcn_mfma_f32_16x16x32_bf16(a_v[ks], bp[i2][ks], o[i2], 0, 0, 0);
#pragma unroll
                for (int i2 = 0; i2 < 2; ++i2) { u32x2 ow; ow.x = pk2(o[i2][0], o[i2][1]); ow.y = pk2(o[i2][2], o[i2][3]); *(u32x2*)(Og + (size_t)(rb + (ih * 2 + i2) * 16 + fr) * 1024) = ow; }
            }
        } else {
            LAS unsigned char* sto = st + ((ci + 1) & 1) * (4 * 4352);
#pragma unroll
            for (int hh = 0; hh < 2; ++hh) {
                f32x4 ev[4]; bf16x8 ak[4][2];
#pragma unroll
                for (int d4 = 0; d4 < 4; ++d4) { const int dt = hh * 4 + d4; ev[d4] = *(const LAS f32x4*)(cur + CH_E + (dt * 16 + fq * 4) * 4);
#pragma unroll
                    for (int ks = 0; ks < 2; ++ks) ak[d4][ks] = *(const LAS bf16x8*)(cur + CH_KH + (dt * 16 + fr) * 144 + ks * 64 + fq * 16); }
#pragma unroll
                for (int d4 = 0; d4 < 4; ++d4) S[hh * 4 + d4] = S[hh * 4 + d4] * ev[d4];
#pragma unroll
                for (int ks = 0; ks < 2; ++ks)
#pragma unroll
                    for (int d4 = 0; d4 < 4; ++d4) S[hh * 4 + d4] = __builtin_amdgcn_mfma_f32_16x16x32_bf16(ak[d4][ks], a_v[ks], S[hh * 4 + d4], 0, 0, 0);
            }
#pragma unroll
            for (int dt = 0; dt < 8; ++dt) { u32x2 w2; w2.x = pk2(S[dt][0], S[dt][1]); w2.y = pk2(S[dt][2], S[dt][3]); *(LAS u32x2*)(sto + fr * 272 + (dt * 16 + fq * 4) * 2) = w2; }
        }
    };
    for (int ci = 0; ci < 68; ci += 2) {
        CH_ISSUE(ci + 2, SET_A);
        step(ci, lds);
        CH_WRITE(1, SET_B);
        __syncthreads();
        CH_ISSUE(ci + 3, SET_B);
        step(ci + 1, lds + CH_BUF);
        CH_WRITE(0, SET_A);
        __syncthreads();
    }
#undef SET_A
#undef SET_B
#undef CH_ISSUE_
#undef CH_WRITE_
#undef CH_ISSUE_X
#undef CH_WRITE_X
#undef CH_ISSUE
#undef CH_WRITE
}
__device__ __forceinline__ void mix_phase(const Params& p, int l, int nrows) {
    const int tid_ = opaque_tid(), lane = tid_ & 63, wave = tid_ >> 6;
    unsigned char* C = p.ws + OFF_C;
    const bf16_t* of = (const bf16_t*)(C + C_OF); const bf16_t* ob = (const bf16_t*)(C + C_OB);
    const bf16_t* pg = (const bf16_t*)(C + C_PG); const bf16_t* pu = (const bf16_t*)(C + C_PU);
    bf16_t* mixed = (bf16_t*)(p.ws + OFF_H);
    const f32x4 ng = *(const f32x4*)(p.gla_norm_g + l * 256 + lane * 4);
    const int stride = gridDim.x * 8;
    int r = blockIdx.x * 8 + wave;
    u32x2 nof[4], nob[4]; u32x2 ngw[4];
#define MIX_LOAD(rr) do { _Pragma("unroll") for (int h = 0; h < 4; ++h) { const size_t o4_ = (size_t)(rr) * 1024 + h * 256 + lane * 4; nof[h] = *(const u32x2*)(of + o4_); nob[h] = *(const u32x2*)(ob + o4_); ngw[h] = *(const u32x2*)(pg + o4_); } } while (0)
    if (r < nrows) MIX_LOAD(r);
    for (; r < nrows; r += stride) {
        u32x2 cof[4], cob[4]; u32x2 cgw[4];
#pragma unroll
        for (int h = 0; h < 4; ++h) { cof[h] = nof[h]; cob[h] = nob[h]; cgw[h] = ngw[h]; }
        int t, seg0, seg1, r0;
        if (r < ROWS_LAT) { t = r & (T - 1); r0 = r - t; seg0 = t & ~63; seg1 = seg0 + 63; } else { t = (r - ROWS_LAT) & (CTXL - 1); r0 = r - t; seg0 = 0; seg1 = CTXL - 1; }
        u32x4 pw0[4], pw1[16], uc[2];
#pragma unroll
        for (int k = 0; k < 4; ++k) { const int tc = min(max(t - 2 + k, seg0), seg1); pw0[k] = *(const u32x4*)(pu + (size_t)(r0 + tc) * 1024 + lane * 8); }
#pragma unroll
        for (int k = 0; k < 16; ++k) { const int tc = min(max(t - 8 + k, seg0), seg1); pw1[k] = *(const u32x4*)(pu + (size_t)(r0 + tc) * 1024 + 512 + lane * 8); }
#pragma unroll
        for (int it = 0; it < 2; ++it) uc[it] = *(const u32x4*)(pu + (size_t)r * 1024 + it * 512 + lane * 8);
        { const int rn = min(r + stride, nrows - 1); MIX_LOAD(rn); }
#pragma unroll
        for (int h = 0; h < 4; ++h) {
            const f32x4 o = (f32x4){bflo(cof[h].x) + bflo(cob[h].x), bfhi(cof[h].x) + bfhi(cob[h].x), bflo(cof[h].y) + bflo(cob[h].y), bfhi(cof[h].y) + bfhi(cob[h].y)};
            const float ss = wave_sum((o[0] * o[0] + o[1] * o[1]) + (o[2] * o[2] + o[3] * o[3]));
            const float rinv = 1.f / sqrtf(ss * (1.f / 256.f) + 1e-6f);
            const u32x2 gw = cgw[h];
            const f32x4 y = o * rinv * ng;
            u32x2 w; w.x = pk2(y[0] * siluf(bflo(gw.x)), y[1] * siluf(bfhi(gw.x))); w.y = pk2(y[2] * siluf(bflo(gw.y)), y[3] * siluf(bfhi(gw.y)));
            *(u32x2*)(mixed + (size_t)r * D + h * 256 + lane * 4) = w;
        }
#pragma unroll
        for (int it = 0; it < 2; ++it) {
            const int c = it * 512 + lane * 8, gi = c >> 8, hw = 1 << gi;
            const int lo = max(t - hw, seg0), hi = min(t + hw - 1, seg1);
            const int kmax = it == 0 ? 4 : 16, tb = t - kmax / 2;
            float s[8];
#pragma unroll
            for (int j = 0; j < 8; ++j) s[j] = 0.f;
#pragma unroll
            for (int k = 0; k < kmax; ++k) { const int tt = tb + k; const bool ok = tt >= lo && tt <= hi;
                u32x4 uw = it == 0 ? pw0[k & 3] : pw1[k];
                if (!ok) uw = (u32x4){0u, 0u, 0u, 0u};
                s[0] += bflo(uw.x); s[1] += bfhi(uw.x); s[2] += bflo(uw.y); s[3] += bfhi(uw.y); s[4] += bflo(uw.z); s[5] += bfhi(uw.z); s[6] += bflo(uw.w); s[7] += bfhi(uw.w); }
            const float inv = 1.f / (float)(hi - lo + 1);
            const u32x4 ucv = uc[it];
            u32x4 w; w.x = pk2(s[0] * inv - bflo(ucv.x), s[1] * inv - bfhi(ucv.x)); w.y = pk2(s[2] * inv - bflo(ucv.y), s[3] * inv - bfhi(ucv.y));
            w.z = pk2(s[4] * inv - bflo(ucv.z), s[5] * inv - bfhi(ucv.z)); w.w = pk2(s[6] * inv - bflo(ucv.w), s[7] * inv - bfhi(ucv.w));
            *(u32x4*)(mixed + (size_t)r * D + 1024 + c) = w;
        }
    }
#undef MIX_LOAD
}


#define XB_TMO      128
#define XB_XCNT(j)  (256  + 64 * (j))
#define XB_XSUB(j)  (1280 + 64 * (j))
#define XB_XGEN(j)  (2304 + 64 * (j))
#define XB_TOP      3328
#define XB_TOPGEN   3392
#define XCD_BAR_WORDS 3456
#define XB_SPIN_CAP (1u << 18)
__device__ __forceinline__ unsigned xb_ld(unsigned* p)              { return __hip_atomic_load(p, __ATOMIC_RELAXED, __HIP_MEMORY_SCOPE_AGENT); }
__device__ __forceinline__ unsigned xb_add(unsigned* p, unsigned v) { return __hip_atomic_fetch_add(p, v, __ATOMIC_RELAXED, __HIP_MEMORY_SCOPE_AGENT); }
__device__ __forceinline__ unsigned xb_xcc_id() { return (unsigned)__builtin_amdgcn_s_getreg((3 << 11) | 20) & 0xFu; }
#define XB_SPIN(cond, bar) do { unsigned _sp = 0; while (cond) { __builtin_amdgcn_s_sleep(1); \
    if ((++_sp & 255u) == 0u) { if (xb_ld(&(bar)[XB_TMO])) break; if (_sp > XB_SPIN_CAP) { atomicAdd(&(bar)[XB_TMO], 1u); break; } } } } while (0)
struct XcdBarrier { unsigned* bar; unsigned x; volatile LAS unsigned* st; };
__device__ __forceinline__ void xcd_barrier_complete(unsigned* bar, unsigned x, unsigned& nloc, unsigned& nx) {
    const unsigned G = gridDim.x * gridDim.y * gridDim.z;
    unsigned sum, cnt, mine, sp = 0u;
    for (;;) {
        sum = 0u; cnt = 0u; mine = 0u;
#pragma unroll
        for (unsigned j = 0; j < 16; ++j) { const unsigned c = xb_ld(&bar[XB_XCNT(j)]); sum += c; cnt += (c > 0u) ? 1u : 0u; mine = (j == x) ? c : mine; }
        if (sum == G) break;
        __builtin_amdgcn_s_sleep(1);
        if ((++sp & 255u) == 0u) { if (xb_ld(&bar[XB_TMO])) break; if (sp > XB_SPIN_CAP) { atomicAdd(&bar[XB_TMO], 1u); break; } }
    }
    nloc = mine > 0u ? mine : 1u; nx = cnt > 0u ? cnt : 1u;
}
__device__ __forceinline__ void xcd_barrier(const XcdBarrier& b) {
    asm volatile("s_waitcnt vmcnt(0)" ::: "memory");
    __syncthreads();
    if (threadIdx.x == 0) {
        unsigned* bar = b.bar;
        __builtin_amdgcn_s_waitcnt(0);
        unsigned nloc = b.st[0], nx = b.st[1];
        if (nloc == 0u) { xcd_barrier_complete(bar, b.x, nloc, nx); b.st[0] = nloc; b.st[1] = nx; }
        const unsigned old = xb_add(&bar[XB_XSUB(b.x)], 1u);
        const unsigned gen = old / nloc;
        if (old + 1u == (gen + 1u) * nloc) {
            __builtin_amdgcn_fence(__ATOMIC_RELEASE, "agent");
            asm volatile("s_waitcnt vmcnt(0)" ::: "memory");
            const unsigned og = xb_add(&bar[XB_TOP], 1u);
            const unsigned tg = og / nx;
            if (og + 1u == (tg + 1u) * nx) xb_add(&bar[XB_TOPGEN], 1u);
            else XB_SPIN(xb_ld(&bar[XB_TOPGEN]) == tg, bar);
            __builtin_amdgcn_fence(__ATOMIC_ACQUIRE, "agent");
            xb_add(&bar[XB_XGEN(b.x)], 1u);
            asm volatile("s_waitcnt vmcnt(0)" ::: "memory");
        } else {
            XB_SPIN(xb_ld(&bar[XB_XGEN(b.x)]) == gen, bar);
            __builtin_amdgcn_fence(__ATOMIC_ACQUIRE, "agent");
            asm volatile("s_waitcnt vmcnt(0)" ::: "memory");
        }
    }
    __syncthreads();
}

typedef const __attribute__((address_space(4))) Params KParams;
#if defined(__HIP_DEVICE_COMPILE__)
__device__ __forceinline__ Params load_params() { KParams* kp = (KParams*)__builtin_amdgcn_kernarg_segment_ptr(); asm volatile("" : "+s"(kp)); return *kp; }
#else
__device__ Params load_params();
#endif
#ifndef PHASE_MASK
#define PHASE_MASK 0xFFFF
#endif
#ifndef DUP_MASK
#define DUP_MASK 0
#endif
#define PH(i) if (PHASE_MASK & (1 << (i))) for (int dup_ = 0; dup_ <= ((DUP_MASK >> (i)) & 1); ++dup_)
__global__ void __launch_bounds__(512, 2) mega(Params p_unused) {
    extern __shared__ __attribute__((aligned(16))) unsigned char shm[];
    cg::grid_group grid = cg::this_grid();
    LAS unsigned char* lds = (LAS unsigned char*)shm;
    LAS float* ldsf = (LAS float*)shm;
    const int G = gridDim.x, bid = blockIdx.x;
#define WSP(off) (p.ws + (off))
    volatile LAS unsigned* xst = (volatile LAS unsigned*)(lds + 144384);
    if (threadIdx.x < 4) xst[threadIdx.x] = 0u;
    __syncthreads();
    { const Params p = load_params(); if (threadIdx.x == 0) (void)xb_add(&((unsigned*)WSP(OFF_BAR))[XB_XCNT(xb_xcc_id())], 1u); }
#define GSYNC() do { const Params pb_ = load_params(); XcdBarrier xb_; xb_.bar = (unsigned*)(pb_.ws + OFF_BAR); xb_.x = xb_xcc_id(); xb_.st = xst; xcd_barrier(xb_); } while (0)
#define CP(off) (p.ws + OFF_C + (off))

    PH(0) { const Params p = load_params();
      for (int it = bid; it < 192; it += G) modp_task(p, 0, it, ldsf);
      convert_phase(p, 0, ldsf, 0, 4352, 0, G); }
    if (gridDim.x == 0x7fffffffu) grid.sync();
    GSYNC();
    PH(1) { const Params p = load_params(); const float* modp = (const float*)WSP(OFF_MODP); float* MOD = (float*)WSP(OFF_MOD);
      for (int i = bid * 512 + threadIdx.x; i < 5 * 12288; i += G * 512) { const int n = i % 12288; float s = p.b_ada[n];
#pragma unroll 8
          for (int k = 0; k < 32; ++k) s += modp[(size_t)k * (2 * 5 * 12288) + i];
          MOD[i] = s; } }
    GSYNC();
    PH(2) { const Params p = load_params(); ln_phase(ROWS, p.x, p.ctx, nullptr, nullptr, nullptr, nullptr, (const float*)WSP(OFF_MOD), 0, 1, (bf16_t*)WSP(OFF_H)); }
    GSYNC();

    for (int l = 0; l < 2; ++l) {
        const int nrows = l == 0 ? ROWS : ROWS_LAT;
        PH(3) { const Params p = load_params(); pg8::StaticOrder S;
          pg8::Gemm g{(const bf16_t*)WSP(OFF_H), (const bf16_t*)WSP(OFF_W), ROWS, NIN, D, D, D, 0}; S.init(g.M, g.N, opaque_s(G), opaque_s(bid));
          EpiIn e{(bf16_t*)CP(C_PK), (bf16_t*)CP(C_VTL), (bf16_t*)CP(C_VTC), (bf16_t*)CP(C_PQ), (bf16_t*)CP(C_PG), (bf16_t*)CP(C_PU), (float*)CP(C_LR), ws_rsrc(p.ws), p.ws};
          pg8::gemm_phase(lds, g, S, e);
          if (bid >= 132) { convert_phase(p, l, ldsf, 4352, CVT_SPLIT, 132, G - 132); convert_phase(p, l, ldsf, CVT_ITEMS - 128, CVT_ITEMS, 132, G - 132); } }
        GSYNC();
        PH(4) { const Params p = load_params(); gla_prep(p, l, lds); }
        GSYNC();
        PH(12) { const Params p = load_params(); gla_chain(p, lds);
          if (bid >= 128) {
            if (bid < 160) {
              pg8::StaticOrder S; bf16_t* wo = (bf16_t*)WSP(OFF_W) + NW_IN;
              pg8::Gemm g{wo + 1024, (const bf16_t*)WSP(OFF_W) + NW_IN + NW_OUT + NW_1 + NW_2, D, 1024, 256, D, 256, 512}; S.init(g.M, g.N, 32, opaque_s(bid - 128));
              EpiPool e{wo, nullptr, ws_rsrc(p.ws), p.ws};
              pg8::gemm_phase(lds, g, S, e); }
            convert_phase(p, l, ldsf, CVT_SPLIT, CVT_ITEMS - 128, 128, G - 128);
            if (l == 0 && bid >= 160) { __syncthreads(); for (int it = bid - 160; it < 192; it += G - 160) modp_task(p, 1, it, ldsf); } } }
        GSYNC();
        PH(5) { const Params p = load_params(); mix_phase(p, l, nrows);
          if (l == 0) { const float* modp = (const float*)WSP(OFF_MODP) + 5 * 12288; float* MOD1 = (float*)WSP(OFF_MOD) + 5 * 12288;
            for (int i = bid * 512 + threadIdx.x; i < 5 * 12288; i += G * 512) { float sacc = p.b_ada[12288 + i % 12288];
#pragma unroll 8
              for (int k = 0; k < 32; ++k) sacc += modp[(size_t)k * (2 * 5 * 12288) + i];
              MOD1[i] = sacc; } } }
        GSYNC();
        PH(7) { const Params p = load_params(); pg8::StaticOrder S;
          pg8::Gemm g{(const bf16_t*)WSP(OFF_H), (const bf16_t*)WSP(OFF_W) + NW_IN, nrows, D, D, D, D, 0};
          if (l == 0) S.init_split(ROWS_LAT, g.N, opaque_s(G), opaque_s(bid), 4, 8); else S.init(g.M, g.N, opaque_s(G), opaque_s(bid));
          EpiDelta e{(bf16_t*)CP(C_PK), (const float*)WSP(OFF_MOD) + (size_t)l * 5 * 12288 + 2 * D, nullptr, (float*)CP(C_PART2), ws_rsrc(p.ws), p.ws};
          pg8::gemm_phase(lds, g, S, e); }
        GSYNC();
        PH(8) { const Params p = load_params(); float* XB = (float*)WSP(OFF_XB);
          const float* modl = (const float*)WSP(OFF_MOD) + (size_t)l * 5 * 12288;
          ln_phase(nrows, l == 0 ? p.x : XB, l == 0 ? p.ctx : XB + (size_t)ROWS_LAT * D, p.ln1_g + l * D, p.ln1_b + l * D, XB, XB + (size_t)ROWS_LAT * D, modl, 3, 4, (bf16_t*)WSP(OFF_H),
                   (const bf16_t*)CP(C_PK), l == 0 ? (const float*)CP(C_PART2) : nullptr, modl + (4 * 6 + 2) * D, nullptr); }
        GSYNC();
        PH(9) { const Params p = load_params(); pg8::StaticOrder S;
          pg8::Gemm g{(const bf16_t*)WSP(OFF_H), (const bf16_t*)WSP(OFF_W) + NW_IN + NW_OUT, nrows, DFF, D, D, D, 0}; S.init(g.M, g.N, opaque_s(G), opaque_s(bid));
          EpiMlp1 e{(bf16_t*)CP(C_A1), p.b_mlp1 + l * DFF, ws_rsrc(p.ws), p.ws};
          pg8::gemm_phase(lds, g, S, e);
          if (l == 0 && bid >= 128) convert_phase(p, 1, ldsf, 0, 4352, 128, G - 128); }
        GSYNC();
        PH(10) { const Params p = load_params(); pg8::StaticOrder S;
          pg8::Gemm g{(const bf16_t*)CP(C_A1), (const bf16_t*)WSP(OFF_W) + NW_IN + NW_OUT + NW_1, nrows, D, DFF, DFF, DFF, 0};
          if (l == 0) S.init_split(ROWS_LAT, g.N, opaque_s(G), opaque_s(bid), 4, 8); else S.init(g.M, g.N, opaque_s(G), opaque_s(bid));
          EpiDelta e{(bf16_t*)WSP(OFF_H), (const float*)WSP(OFF_MOD) + (size_t)l * 5 * 12288 + 5 * D, p.b_mlp2 + l * D, (float*)CP(C_PART4), ws_rsrc(p.ws), p.ws};
          pg8::gemm_phase(lds, g, S, e); }
        GSYNC();
        PH(11) { const Params p = load_params(); float* XB = (float*)WSP(OFF_XB);
          if (l == 0) {
            ln_phase(ROWS, XB, XB + (size_t)ROWS_LAT * D, p.ln2_g, p.ln2_b, XB, XB + (size_t)ROWS_LAT * D, (const float*)WSP(OFF_MOD) + (size_t)5 * 12288, 0, 1, (bf16_t*)WSP(OFF_H),
                     (const bf16_t*)WSP(OFF_H), (const float*)CP(C_PART4), (const float*)WSP(OFF_MOD) + (4 * 6 + 5) * D, p.b_mlp2);
          } else {
            ln_phase(ROWS_LAT, XB, nullptr, p.ln2_g + D, p.ln2_b + D, p.out, nullptr, nullptr, 0, 0, nullptr, (const bf16_t*)WSP(OFF_H));
          } }
        if (l == 0) GSYNC();
    }
}

extern "C" void kernel_launch(void* const* d_in, const int* in_sizes, int n_in, void* d_out, int out_size, void* d_ws, size_t ws_size, hipStream_t stream) {
    constexpr int LDS_BYTES = 144384 + 16;
    static int grid = 0;
    if (grid == 0) {
        if (n_in != 21 || ws_size < WS_NEED) { fprintf(stderr, "kernel_launch: need 21 inputs and %zu bytes of workspace; got %d, %zu\n", (size_t)WS_NEED, n_in, ws_size); grid = -1; return; }
        int dev = 0, cus = 0, per_cu = 0;
        hipGetDevice(&dev); hipDeviceGetAttribute(&cus, hipDeviceAttributeMultiprocessorCount, dev);
        if (hipFuncSetAttribute((const void*)mega, hipFuncAttributeMaxDynamicSharedMemorySize, LDS_BYTES) != hipSuccess) { fprintf(stderr, "kernel_launch: hipFuncSetAttribute failed\n"); grid = -1; return; }
        if (hipOccupancyMaxActiveBlocksPerMultiprocessor(&per_cu, (const void*)mega, 512, LDS_BYTES) != hipSuccess || per_cu < 1) { fprintf(stderr, "kernel_launch: occupancy query gave %d\n", per_cu); per_cu = 1; }
        (void)hipGetLastError();
        grid = cus * 1;
        fprintf(stderr, "kernel_launch: grid %d (per_cu %d)\n", grid, per_cu);
    }
    if (grid < 0) return;
    if (hipMemsetAsync((unsigned char*)d_ws + OFF_BAR, 0, 16384, stream) != hipSuccess) { fprintf(stderr, "kernel_launch: memset failed\n"); return; }
    Params p{};
    const float** pp = (const float**)&p;
    for (int i = 0; i < 21; ++i) pp[i] = (const float*)d_in[i];
    p.out = (float*)d_out; p.ws = (unsigned char*)d_ws;
    void* args[] = {&p};
    hipError_t e = hipLaunchCooperativeKernel((const void*)mega, dim3(grid), dim3(512), args, LDS_BYTES, stream);
    if (e != hipSuccess) fprintf(stderr, "kernel_launch: cooperative launch failed: %s (grid %d)\n", hipGetErrorString(e), grid);
}
```

```cpp
#include <hip/hip_runtime.h>
#include <hip/hip_cooperative_groups.h>
#include <cstdio>
namespace cg = cooperative_groups;

#define LAS __attribute__((address_space(3)))
typedef unsigned short bf16_t;
typedef short bf16x8 __attribute__((ext_vector_type(8)));
typedef float f32x4 __attribute__((ext_vector_type(4)));
typedef unsigned u32x4 __attribute__((ext_vector_type(4)));
typedef unsigned u32x2 __attribute__((ext_vector_type(2)));

constexpr int D = 2048, NB = 4, T = 4096, CTXL = 256, DFF = 8192;
constexpr int ROWS_LAT = NB * T, ROWS_CTX = NB * CTXL, ROWS = ROWS_LAT + ROWS_CTX;
constexpr int NIN = 4352;
constexpr float ALPHA = 1.4142135623730951f;
constexpr float QSCALE = 0.08838834764831845f;

constexpr size_t SZ_XB = (size_t)ROWS * D * 4, SZ_H = (size_t)ROWS * D * 2;
constexpr size_t NW_IN = (size_t)NIN * D, NW_OUT = (size_t)D * D, NW_1 = (size_t)DFF * D, NW_2 = (size_t)D * DFF, NW_POOL = 4 * 256 * 256;
constexpr size_t SZ_W = (NW_IN + NW_OUT + NW_1 + NW_2 + NW_POOL) * 2;
constexpr size_t SZ_MODP = 32ull * 2 * 5 * 12288 * 4, SZ_MOD = 2ull * 5 * 12288 * 4;
constexpr size_t OFF_XB = 0, OFF_H = OFF_XB + SZ_XB, OFF_W = OFF_H + SZ_H, OFF_MODP = OFF_W + SZ_W, OFF_MOD = OFF_MODP + SZ_MODP, OFF_BAR = OFF_MOD + SZ_MOD  , OFF_C = OFF_BAR + 16384;
constexpr size_t C_PK = 0, C_PV = C_PK + (size_t)ROWS * 512 * 2, C_PQ = C_PV + (size_t)ROWS * 1024 * 2, C_PG = C_PQ + (size_t)ROWS * 512 * 2, C_PU = C_PG + (size_t)ROWS * 1024 * 2,
                 C_LR = C_PU + (size_t)ROWS * 1024 * 2, C_QT = C_LR + (size_t)ROWS * 32 * 4, C_KHT = C_QT + (size_t)2 * ROWS * 512 * 2, C_P = C_KHT + (size_t)2 * ROWS * 512 * 2,
                 C_VT = C_P + (size_t)2176 * 4096 * 2, C_E = C_VT + (size_t)ROWS * 1024 * 2, C_OB = C_E + (size_t)2176 * 128 * 4, C_END = C_OB + (size_t)ROWS * 1024 * 4;
constexpr size_t C_OF = C_PK;
constexpr size_t C_VTL = C_VT, C_VTC = C_VT + (size_t)ROWS_LAT * 1024 * 2;
constexpr size_t C_RESID = C_VT;
constexpr size_t C_A1 = 0;
constexpr size_t C_PART2 = C_QT;
constexpr size_t C_PART4 = (size_t)ROWS * 8192 * 2;
constexpr size_t SZ_PART = (size_t)8 * ROWS_CTX * D * 4;
static_assert(SZ_PART <= C_P - C_QT, "PART2 fits");
constexpr size_t WS_NEED = OFF_C + (C_PART4 + SZ_PART > C_END ? C_PART4 + SZ_PART : C_END);
static_assert((size_t)ROWS * 8192 * 2 <= C_END, "A1 fits");

struct Params {
    const float *x, *c, *ctx, *c_ctx, *w_ada, *b_ada, *w_in, *w_gate_up, *b_gate, *gla_norm_g, *w_pool, *pool_scale, *w_out, *ln1_g, *ln1_b, *w_mlp1, *b_mlp1, *w_mlp2, *b_mlp2, *ln2_g, *ln2_b;
    float* out; unsigned char* ws;
};

typedef __bf16 v2bf_t __attribute__((ext_vector_type(2)));
typedef float v2f_t __attribute__((ext_vector_type(2)));
__device__ __forceinline__ unsigned pk2(float lo, float hi) { const v2f_t f = {lo, hi}; const v2bf_t b = __builtin_convertvector(f, v2bf_t); return __builtin_bit_cast(unsigned, b); }
__device__ __forceinline__ bf16_t bf1(float v) { return (bf16_t)pk2(v, 0.f); }
__device__ __forceinline__ float bflo(unsigned w) { return __uint_as_float(w << 16); }
__device__ __forceinline__ float bfhi(unsigned w) { return __uint_as_float(w & 0xffff0000u); }
__device__ __forceinline__ float wave_sum(float v) {
#pragma unroll
    for (int o = 1; o < 64; o <<= 1) v += __shfl_xor(v, o);
    return v;
}
__device__ __forceinline__ int opaque_tid() { int t = threadIdx.x; asm volatile("" : "+v"(t)); return t; }
__device__ __forceinline__ int opaque_s(int v) { asm volatile("" : "+s"(v)); return v; }
__device__ __forceinline__ float siluf(float v) { return v / (1.f + __expf(-v)); }
__device__ __forceinline__ float log_sigmoidf(float z) { return fminf(z, 0.f) - log1pf(__expf(-fabsf(z))); }

namespace pg8 {
constexpr int BM = 256, BK = 64, HALF = 128, HTB = HALF * BK * 2, STAGE_BYTES = 8 * HTB, NXCD = 8, WGM = 8;
__host__ __device__ __forceinline__ int lds_byte(int r, int c) { const int st = (r >> 4) * 2 + (c >> 5), rr = r & 15, cc = c & 31, ob = rr * 64 + cc * 2; return st * 1024 + (ob ^ (((ob >> 9) & 1) << 5)); }
__host__ __device__ __forceinline__ void stage_rc(int b, int& R, int& C) { const int st = b / 1024, sb = b % 1024, swz = sb ^ (((sb >> 9) & 1) << 5); R = (st >> 1) * 16 + swz / 64; C = (st & 1) * 32 + (swz % 64) / 2; }
__host__ __device__ __forceinline__ int perm32(int rho) { const int n = rho >> 4, i = rho & 15; return 8 * (i >> 2) + 4 * n + (i & 3); }
struct Unit { int pm, pn, kt0, nkt, part; };
struct Gemm { const bf16_t* A; const bf16_t* Bt; int M, N, K, lda, ldb, a_pn_off; };
struct StaticOrder {
    int nM, nN, nwg, G, c, nt, ks, nsub;
    __device__ __forceinline__ void init(int M, int N, int G_, int c_) { nM = M / BM; nN = N / BM; nwg = nM * nN; G = G_; c = c_; nt = 0; ks = 1; nsub = 0; }
    __device__ __forceinline__ void init_split(int Mlat, int N, int G_, int c_, int ctx_tiles, int ks_) { nM = Mlat / BM; nN = N / BM; nwg = nM * nN; G = G_; c = c_; nt = 0; ks = ks_; nsub = ctx_tiles * nN * ks_; }
    __device__ __forceinline__ Unit next(int i) const {
        Unit u; u.pm = 0; u.pn = 0; u.kt0 = 0; u.nkt = 0; u.part = -1;
        const long L = (long)i * G + c;
        if (L >= nwg) { const int sidx = (int)(L - nwg);
            if (sidx < nsub) { const int tile = sidx / ks; u.part = sidx % ks; u.pm = nM + tile / nN; u.pn = tile % nN; u.nkt = nt / ks; u.kt0 = u.part * u.nkt; }
            return u; }
        int wgid = (int)L; { const int q = nwg / NXCD, r = nwg % NXCD, xcd = wgid % NXCD, off = wgid / NXCD; wgid = (xcd < r ? xcd * (q + 1) : r * (q + 1) + (xcd - r) * q) + off; }
        const int nig = WGM * nN, gid = wgid / nig, fm = gid * WGM, gsz = (nM - fm) < WGM ? (nM - fm) : WGM;
        u.pm = fm + ((wgid % nig) % gsz); u.pn = (wgid % nig) / gsz; u.nkt = nt; return u;
    }
};

template <class Epi>
__device__ __forceinline__ void gemm_phase(LAS unsigned char* lds, const Gemm g, StaticOrder S, const Epi& E) {
    const int tid = opaque_tid(), wid = __builtin_amdgcn_readfirstlane(tid >> 6), lane = tid & 63, wr = wid >> 2, wc = wid & 3, fr = lane & 15, fq = lane >> 4;
    int K_ = g.K; asm volatile("" : "+s"(K_));
    const int K = K_; S.nt = K / BK;
    unsigned voffA[2], voffB[2];
#pragma unroll
    for (int i = 0; i < 2; ++i) { int R, C; stage_rc(tid * 16 + i * 8192, R, C); const int Rb = Epi::PERM ? ((R & ~31) + perm32(R & 31)) : R;
        voffA[i] = (unsigned)(R * g.lda + C) * 2u; voffB[i] = (unsigned)(Rb * g.ldb + C) * 2u; }
    const size_t kstep = (size_t)(BK * 2);
    const size_t hstepA = (size_t)HALF * g.lda * 2, hstepB = (size_t)HALF * g.ldb * 2;
    const size_t tstepA = 2 * hstepA, tstepB = 2 * hstepB;
    const unsigned ldsw = (unsigned)wid * 1024u;
    const int aoff = lds_byte(wr * 64 + fr, fq * 8), boff = lds_byte(wc * 32 + fr, fq * 8);
#define PG8_SA(b, h) (((b) * 2 + (h)) * HTB)
#define PG8_SB(b, h) ((4 + (b) * 2 + (h)) * HTB)
#define PG8_STAGE(bufoff, gbase, voff) do { _Pragma("unroll") for (int _i = 0; _i < 2; ++_i) \
        __builtin_amdgcn_global_load_lds((const unsigned*)((const char*)(gbase) + (voff)[_i]), (LAS unsigned*)(lds + (bufoff) + ldsw + _i * 8192), 16, 0, 0); } while (0)
#define PG8_LDA(dst, b, h) do { _Pragma("unroll") for (int m = 0; m < 4; ++m) _Pragma("unroll") for (int k = 0; k < 2; ++k) dst[m][k] = *(const LAS bf16x8*)(lds + PG8_SA(b, h) + aoff + m * 2048 + k * 1024); } while (0)
#define PG8_LDB(dst, b, h) do { _Pragma("unroll") for (int n = 0; n < 2; ++n) _Pragma("unroll") for (int k = 0; k < 2; ++k) dst[n][k] = *(const LAS bf16x8*)(lds + PG8_SB(b, h) + boff + n * 2048 + k * 1024); } while (0)
#define PG8_MMA(ai, bj, At, Bt) do { __builtin_amdgcn_s_setprio(1); _Pragma("unroll") for (int m = 0; m < 4; ++m) _Pragma("unroll") for (int n = 0; n < 2; ++n) _Pragma("unroll") for (int k = 0; k < 2; ++k) \
        acc[ai][bj][m][n] = __builtin_amdgcn_mfma_f32_16x16x32_bf16(Bt[n][k], At[m][k], acc[ai][bj][m][n], 0, 0, 0); __builtin_amdgcn_s_setprio(0); } while (0)
#define PG8_WAIT_V(n) asm volatile("s_waitcnt vmcnt(" #n ")" ::: "memory")
#define PG8_WAIT_L(n) asm volatile("s_waitcnt lgkmcnt(" #n ")" ::: "memory")
#define PG8_BAR __builtin_amdgcn_s_barrier()
#define PG8_SCHED __builtin_amdgcn_sched_barrier(0)
    Unit cur = S.next(0), nxt; int ui = 0;
    if (cur.nkt == 0) return;
    f32x4 acc[2][2][4][2];
#pragma unroll
    for (int a = 0; a < 2; ++a)
#pragma unroll
        for (int b = 0; b < 2; ++b)
#pragma unroll
            for (int m = 0; m < 4; ++m)
#pragma unroll
                for (int n = 0; n < 2; ++n) acc[a][b][m][n] = (f32x4){0.f, 0.f, 0.f, 0.f};
    bf16x8 At[4][2], B0[2][2], B1[2][2];
    const char* cA = (const char*)g.A + (size_t)cur.pm * tstepA + (size_t)cur.pn * g.a_pn_off + (size_t)cur.kt0 * kstep; const char* cB = (const char*)g.Bt + (size_t)cur.pn * tstepB + (size_t)cur.kt0 * kstep;
    PG8_STAGE(PG8_SB(0, 0), cB, voffB); PG8_STAGE(PG8_SA(0, 0), cA, voffA); PG8_STAGE(PG8_SB(0, 1), cB + hstepB, voffB); PG8_STAGE(PG8_SA(0, 1), cA + hstepA, voffA);
    if (wr == 1) PG8_BAR;
    PG8_WAIT_V(4); PG8_BAR;
    PG8_STAGE(PG8_SB(1, 0), cB + kstep, voffB); PG8_STAGE(PG8_SA(1, 0), cA + kstep, voffA); PG8_STAGE(PG8_SB(1, 1), cB + hstepB + kstep, voffB);
    PG8_WAIT_V(6); PG8_BAR;
    for (;;) {
        nxt = S.next(ui + 1); const bool has_next = nxt.nkt != 0;
        const char* nA = has_next ? (const char*)g.A + (size_t)nxt.pm * tstepA + (size_t)nxt.pn * g.a_pn_off + (size_t)nxt.kt0 * kstep : cA; const char* nB = has_next ? (const char*)g.Bt + (size_t)nxt.pn * tstepB + (size_t)nxt.kt0 * kstep : cB;
        const int ntc = cur.nkt;
        for (int t = 0; t < ntc; t += 2) {
            const bool last = (t == ntc - 2);
            const char* a1 = cA + (size_t)(t + 1) * kstep;
            const char* a2 = last ? nA : cA + (size_t)(t + 2) * kstep; const char* b2 = last ? nB : cB + (size_t)(t + 2) * kstep;
            const char* a3 = a2 + kstep; const char* b3 = b2 + kstep;
            PG8_LDB(B0, 0, 0); PG8_SCHED; PG8_LDA(At, 0, 0); PG8_STAGE(PG8_SA(1, 1), a1 + hstepA, voffA);
            PG8_WAIT_L(8); PG8_BAR; PG8_WAIT_L(0); PG8_MMA(0, 0, At, B0); PG8_BAR; PG8_SCHED;
            PG8_LDB(B1, 0, 1); PG8_STAGE(PG8_SB(0, 0), b2, voffB);
            PG8_BAR; PG8_WAIT_L(0); PG8_MMA(0, 1, At, B1); PG8_BAR;
            PG8_LDA(At, 0, 1); PG8_STAGE(PG8_SA(0, 0), a2, voffA);
            PG8_BAR; PG8_WAIT_L(0); PG8_MMA(1, 0, At, B0); PG8_BAR; PG8_SCHED;
            PG8_STAGE(PG8_SB(0, 1), b2 + hstepB, voffB);
            PG8_WAIT_V(6); PG8_BAR; PG8_MMA(1, 1, At, B1); PG8_BAR;
            PG8_LDB(B0, 1, 0); PG8_SCHED; PG8_LDA(At, 1, 0); PG8_STAGE(PG8_SA(0, 1), a2 + hstepA, voffA);
            PG8_WAIT_L(8); PG8_BAR; PG8_WAIT_L(0); PG8_MMA(0, 0, At, B0); PG8_BAR; PG8_SCHED;
            PG8_LDB(B1, 1, 1); PG8_STAGE(PG8_SB(1, 0), b3, voffB);
            PG8_BAR; PG8_WAIT_L(0); PG8_MMA(0, 1, At, B1); PG8_BAR;
            PG8_LDA(At, 1, 1); PG8_STAGE(PG8_SA(1, 0), a3, voffA);
            PG8_BAR; PG8_WAIT_L(0); PG8_MMA(1, 0, At, B0); PG8_BAR; PG8_SCHED;
            PG8_STAGE(PG8_SB(1, 1), b3 + hstepB, voffB);
            PG8_WAIT_V(6); PG8_BAR; PG8_MMA(1, 1, At, B1); PG8_BAR;
        }
        E(acc, cur, wr, wc, fr, fq);
        if (!has_next) break;
#pragma unroll
        for (int a = 0; a < 2; ++a)
#pragma unroll
            for (int b = 0; b < 2; ++b)
#pragma unroll
                for (int m = 0; m < 4; ++m)
#pragma unroll
                    for (int n = 0; n < 2; ++n) acc[a][b][m][n] = (f32x4){0.f, 0.f, 0.f, 0.f};
        cur = nxt; cA = nA; cB = nB; ++ui;
    }
    PG8_WAIT_V(0);
    if (wr == 0) PG8_BAR;
    PG8_BAR;
#undef PG8_SA
#undef PG8_SB
#undef PG8_STAGE
#undef PG8_LDA
#undef PG8_LDB
#undef PG8_MMA
#undef PG8_WAIT_V
#undef PG8_WAIT_L
#undef PG8_BAR
#undef PG8_SCHED
}
}
using pg8::Unit;

struct EpiIn {
    static constexpr bool PERM = true;
    bf16_t *pk, *vtl, *vtc, *pq, *pg, *pu; float* lr;
    __device__ __forceinline__ void operator()(const f32x4 (&acc)[2][2][4][2], const Unit& u, int wr, int wc, int fr, int fq) const {
        const int row0 = u.pm * 256 + wr * 64 + fr;
        if (u.pn >= 2 && u.pn < 6) {
            const int cb = (u.pn - 2) * 256 + wc * 32 + 8 * fq;
            bf16_t* vb; int tl, t0;
            if (u.pm < 64) { vb = vtl + (size_t)(u.pm >> 4) * 1024 * T; tl = T; t0 = (u.pm & 15) * 256; } else { vb = vtc + (size_t)(u.pm - 64) * 1024 * CTXL; tl = CTXL; t0 = 0; }
            t0 += wr * 64 + fr;
#pragma unroll
            for (int ai = 0; ai < 2; ++ai)
#pragma unroll
                for (int m = 0; m < 4; ++m) { bf16_t* tp = vb + t0 + ai * 128 + m * 16;
#pragma unroll
                    for (int bj = 0; bj < 2; ++bj)
#pragma unroll
                        for (int n = 0; n < 2; ++n) { const f32x4 v = acc[ai][bj][m][n]; const unsigned w0 = pk2(v[0], v[1]), w1 = pk2(v[2], v[3]); const size_t c = (size_t)(cb + bj * 128 + 4 * n) * tl;
                            tp[c] = (bf16_t)w0; tp[c + tl] = (bf16_t)(w0 >> 16); tp[c + 2 * (size_t)tl] = (bf16_t)w1; tp[c + 3 * (size_t)tl] = (bf16_t)(w1 >> 16); } }
        } else if (u.pn < 16) {
            bf16_t* base; int ld, colt;
            if (u.pn < 2) { base = pk; ld = 512; colt = u.pn * 256; }
            else if (u.pn < 8) { base = pq; ld = 512; colt = (u.pn - 6) * 256; }
            else if (u.pn < 12) { base = pg; ld = 1024; colt = (u.pn - 8) * 256; }
            else { base = pu; ld = 1024; colt = (u.pn - 12) * 256; }
            const int col0 = colt + wc * 32 + 8 * fq;
#pragma unroll
            for (int ai = 0; ai < 2; ++ai)
#pragma unroll
                for (int m = 0; m < 4; ++m) { bf16_t* rowp = base + (size_t)(row0 + ai * 128 + m * 16) * ld + col0;
#pragma unroll
                    for (int bj = 0; bj < 2; ++bj) { const f32x4 v0 = acc[ai][bj][m][0], v1 = acc[ai][bj][m][1];
                        u32x4 w; w.x = pk2(v0[0], v0[1]); w.y = pk2(v0[2], v0[3]); w.z = pk2(v1[0], v1[1]); w.w = pk2(v1[2], v1[3]);
                        *(u32x4*)(rowp + bj * 128) = w; } }
        } else if (wc == 0) {
#pragma unroll
            for (int ai = 0; ai < 2; ++ai)
#pragma unroll
                for (int m = 0; m < 4; ++m) { float* rowp = lr + (size_t)(row0 + ai * 128 + m * 16) * 32 + 8 * fq;
                    *(f32x4*)(rowp) = acc[ai][0][m][0]; *(f32x4*)(rowp + 4) = acc[ai][0][m][1]; }
        }
    }
};
struct EpiPool {
    static constexpr bool PERM = true;
    bf16_t* mixed; const float* scale;
    __device__ __forceinline__ void operator()(const f32x4 (&acc)[2][2][4][2], const Unit& u, int wr, int wc, int fr, int fq) const {
        const int row0 = u.pm * 256 + wr * 64 + fr, col0 = u.pn * 256 + wc * 32 + 8 * fq;
        f32x4 sv[2][2];
#pragma unroll
        for (int bj = 0; bj < 2; ++bj)
#pragma unroll
            for (int n = 0; n < 2; ++n) sv[bj][n] = scale ? *(const f32x4*)(scale + col0 + bj * 128 + 4 * n) : (f32x4){1.f, 1.f, 1.f, 1.f};
#pragma unroll
        for (int ai = 0; ai < 2; ++ai)
#pragma unroll
            for (int m = 0; m < 4; ++m) { bf16_t* rowp = mixed + (size_t)(row0 + ai * 128 + m * 16) * D + 1024 + col0;
#pragma unroll
                for (int bj = 0; bj < 2; ++bj) { const f32x4 v0 = acc[ai][bj][m][0] * sv[bj][0], v1 = acc[ai][bj][m][1] * sv[bj][1];
                    u32x4 w; w.x = pk2(v0[0], v0[1]); w.y = pk2(v0[2], v0[3]); w.z = pk2(v1[0], v1[1]); w.w = pk2(v1[2], v1[3]);
                    *(u32x4*)(rowp + bj * 128) = w; } }
    }
};
struct EpiMlp1 {
    static constexpr bool PERM = true;
    bf16_t* a1; const float* bias;
    __device__ __forceinline__ void operator()(const f32x4 (&acc)[2][2][4][2], const Unit& u, int wr, int wc, int fr, int fq) const {
        const int row0 = u.pm * 256 + wr * 64 + fr, col0 = u.pn * 256 + wc * 32 + 8 * fq;
        f32x4 bv[2][2];
#pragma unroll
        for (int bj = 0; bj < 2; ++bj)
#pragma unroll
            for (int n = 0; n < 2; ++n) bv[bj][n] = *(const f32x4*)(bias + col0 + bj * 128 + 4 * n);
#pragma unroll
        for (int ai = 0; ai < 2; ++ai)
#pragma unroll
            for (int m = 0; m < 4; ++m) { bf16_t* rowp = a1 + (size_t)(row0 + ai * 128 + m * 16) * DFF + col0;
#pragma unroll
                for (int bj = 0; bj < 2; ++bj) { f32x4 v0 = acc[ai][bj][m][0] + bv[bj][0], v1 = acc[ai][bj][m][1] + bv[bj][1];
#pragma unroll
                    for (int j = 0; j < 4; ++j) { const float a = fmaxf(v0[j], 0.f), b = fmaxf(v1[j], 0.f); v0[j] = a * a; v1[j] = b * b; }
                    u32x4 w; w.x = pk2(v0[0], v0[1]); w.y = pk2(v0[2], v0[3]); w.z = pk2(v1[0], v1[1]); w.w = pk2(v1[2], v1[3]);
                    *(u32x4*)(rowp + bj * 128) = w; } }
    }
};
struct EpiDelta {
    static constexpr bool PERM = true;
    bf16_t* delta; const float* gate  ; const float* bias; float* part  ;
    __device__ __forceinline__ void operator()(const f32x4 (&acc)[2][2][4][2], const Unit& u, int wr, int wc, int fr, int fq) const {
        const int row0 = u.pm * 256 + wr * 64 + fr, col0 = u.pn * 256 + wc * 32 + 8 * fq;
        if (u.part >= 0) {
            float* pp = part + ((size_t)u.part * ROWS_CTX + (row0 - ROWS_LAT)) * D + col0;
#pragma unroll
            for (int ai = 0; ai < 2; ++ai)
#pragma unroll
                for (int m = 0; m < 4; ++m)
#pragma unroll
                    for (int bj = 0; bj < 2; ++bj)
#pragma unroll
                        for (int n = 0; n < 2; ++n) *(f32x4*)(pp + (size_t)(ai * 128 + m * 16) * D + bj * 128 + 4 * n) = acc[ai][bj][m][n];
            return;
        }
        const int mr = u.pm < 64 ? (u.pm >> 4) : 4;
        const float* gp = gate + (size_t)mr * 6 * D + col0;
        f32x4 gv[2][2], bv[2][2];
#pragma unroll
        for (int bj = 0; bj < 2; ++bj)
#pragma unroll
            for (int n = 0; n < 2; ++n) { gv[bj][n] = *(const f32x4*)(gp + bj * 128 + 4 * n); bv[bj][n] = bias ? *(const f32x4*)(bias + col0 + bj * 128 + 4 * n) : (f32x4){0.f, 0.f, 0.f, 0.f}; }
#pragma unroll
        for (int ai = 0; ai < 2; ++ai)
#pragma unroll
            for (int m = 0; m < 4; ++m) { bf16_t* rowp = delta + (size_t)(row0 + ai * 128 + m * 16) * D + col0;
#pragma unroll
                for (int bj = 0; bj < 2; ++bj) { const f32x4 v0 = gv[bj][0] * (acc[ai][bj][m][0] + bv[bj][0]), v1 = gv[bj][1] * (acc[ai][bj][m][1] + bv[bj][1]);
                    u32x4 w; w.x = pk2(v0[0], v0[1]); w.y = pk2(v0[2], v0[3]); w.z = pk2(v1[0], v1[1]); w.w = pk2(v1[2], v1[3]);
                    *(u32x4*)(rowp + bj * 128) = w; } }
    }
};

__device__ __forceinline__ void modp_task(const Params& p, int l, int task, LAS float* sl) {
    const int tid = opaque_tid();
    const int s = task / 6, nb = task % 6;
    const int k0 = s * 64, n0 = nb * 2048 + tid * 4;
    if (tid < 320) { const int r = tid >> 6, kk = tid & 63; const float cv = r < 4 ? p.c[r * D + k0 + kk] : p.c_ctx[k0 + kk]; sl[tid] = siluf(cv); }
    __syncthreads();
    f32x4 acc[5];
#pragma unroll
    for (int r = 0; r < 5; ++r) acc[r] = (f32x4){0.f, 0.f, 0.f, 0.f};
    const float* wp = p.w_ada + ((size_t)l * D + k0) * 12288 + n0;
#pragma unroll 8
    for (int kk = 0; kk < 64; ++kk) { const f32x4 w = __builtin_nontemporal_load((const f32x4*)(wp + (size_t)kk * 12288));
#pragma unroll
        for (int r = 0; r < 5; ++r) acc[r] += sl[r * 64 + kk] * w; }
    float* mp = (float*)(p.ws + OFF_MODP) + ((size_t)(s * 2 + l) * 5) * 12288 + n0;
#pragma unroll
    for (int r = 0; r < 5; ++r) *(f32x4*)(mp + (size_t)r * 12288) = acc[r];
    __syncthreads();
}
constexpr int CVT_ITEMS = 4352 + 2048 + 8192 + 8192 + 128;
constexpr int CVT_SPLIT = 4352 + 5500;
__device__ __forceinline__ void convert_item(const Params& p, int l, int it, LAS float* scr, int lane) {
    const float* src; bf16_t* dst; int K, ld, nbn, mode = 0, pgi = 0;
    bf16_t* wb = (bf16_t*)(p.ws + OFF_W);
    if (it < 4352) { src = p.w_in + (size_t)l * D * 4128; ld = 4128; K = 2048; nbn = 136; dst = wb; mode = 1; }
    else if ((it -= 4352) < 2048) { src = p.w_out + (size_t)l * D * D; ld = 2048; K = 2048; nbn = 64; dst = wb + NW_IN; }
    else if ((it -= 2048) < 8192) { src = p.w_mlp1 + (size_t)l * D * DFF; ld = 8192; K = 2048; nbn = 256; dst = wb + NW_IN + NW_OUT; }
    else if ((it -= 8192) < 8192) { src = p.w_mlp2 + (size_t)l * DFF * D; ld = 2048; K = 8192; nbn = 64; dst = wb + NW_IN + NW_OUT + NW_1; }
    else { it -= 8192; const int gi = it >> 5; it &= 31; src = p.w_pool + ((size_t)l * 4 + gi) * 65536; ld = 256; K = 256; nbn = 8; dst = wb + NW_IN + NW_OUT + NW_1 + NW_2 + (size_t)gi * 65536; mode = 2; pgi = gi; }
    const int kb = it / nbn, nb = it % nbn, k0 = 64 * kb, n0 = 32 * nb;
    if (mode == 2) {
        const float sc_ = p.pool_scale[l * 1024 + pgi * 256 + n0 + (lane & 31)];
#pragma unroll 8
        for (int i = 0; i < 32; ++i) { const int kk = 2 * i + (lane >> 5); dst[(size_t)(k0 + kk) * 256 + n0 + (lane & 31)] = bf1(src[(size_t)(k0 + kk) * 256 + n0 + (lane & 31)] * sc_); }
        return;
    }
    int ns = n0;
    if (mode == 1) ns = n0 < 1536 ? n0 : (n0 < 4096 ? n0 + 32 : (n0 < 4128 ? 1536 + (n0 - 4096) : -1));
    if (ns >= 0) {
        const int kr = lane >> 3, nq = lane & 7; f32x4 t[8];
#pragma unroll
        for (int i = 0; i < 8; ++i) t[i] = __builtin_nontemporal_load((const f32x4*)(src + (size_t)(k0 + 8 * i + kr) * ld + ns + 4 * nq));
#pragma unroll
        for (int i = 0; i < 8; ++i) { LAS float* q = scr + (8 * i + kr) * 33 + 4 * nq; q[0] = t[i][0]; q[1] = t[i][1]; q[2] = t[i][2]; q[3] = t[i][3]; }
    } else {
#pragma unroll 8
        for (int i = 0; i < 32; ++i) { const int kk = 2 * i + (lane >> 5); scr[kk * 33 + (lane & 31)] = 0.f; }
    }
    asm volatile("s_waitcnt lgkmcnt(0)" ::: "memory");
    const int c = lane & 7;
#pragma unroll
    for (int j = 0; j < 4; ++j) { const int n = (lane >> 3) + 8 * j; const LAS float* s = scr + (8 * c) * 33 + n;
        u32x4 o; o.x = pk2(s[0 * 33], s[1 * 33]); o.y = pk2(s[2 * 33], s[3 * 33]); o.z = pk2(s[4 * 33], s[5 * 33]); o.w = pk2(s[6 * 33], s[7 * 33]);
        *(u32x4*)(dst + (size_t)(n0 + n) * K + k0 + 8 * c) = o; }
    asm volatile("s_waitcnt lgkmcnt(0)" ::: "memory");
}
__device__ __forceinline__ void convert_phase(const Params& p, int l, LAS float* ldsf, int it_lo, int it_hi, int wg0, int nwg) {
    const int tid = opaque_tid(), lane = tid & 63, wave = tid >> 6;
    LAS float* scr = ldsf + wave * (64 * 33);
    for (int it = it_lo + ((int)blockIdx.x - wg0) * 8 + wave; it < it_hi; it += nwg * 8) convert_item(p, l, it, scr, lane);
}
__device__ __forceinline__ void ln_phase(int nrows, const float* src_lat, const float* src_ctx, const float* g, const float* b, float* dst_lat, float* dst_ctx,
                                         const float* modl  , int jsh, int jsc, bf16_t* hout,
                                         const bf16_t* delta = nullptr, const float* part = nullptr, const float* pgate = nullptr, const float* pbias = nullptr) {
    const int tid_ = opaque_tid(), lane = tid_ & 63, wave = tid_ >> 6;
    const int stride = gridDim.x * 8;
    int r = blockIdx.x * 8 + wave;
    f32x4 nv[8]; u32x4 nd[4];
#define LN_C(i) ((lane + 64 * ((i) >> 1)) * 8 + ((i) & 1) * 4)
#define LN_LOAD(rr) do { const float* src_ = (rr) < ROWS_LAT ? src_lat + (size_t)(rr) * D : src_ctx + (size_t)((rr) - ROWS_LAT) * D; \
        _Pragma("unroll") for (int i = 0; i < 8; ++i) nv[i] = *(const f32x4*)(src_ + LN_C(i)); \
        if (delta) { const bf16_t* dp_ = delta + (size_t)(rr) * D; _Pragma("unroll") for (int i = 0; i < 4; ++i) nd[i] = *(const u32x4*)(dp_ + (lane + 64 * i) * 8); } } while (0)
#pragma unroll
    for (int i = 0; i < 4; ++i) nd[i] = (u32x4){0u, 0u, 0u, 0u};
    if (r < nrows) LN_LOAD(r);
    for (; r < nrows; r += stride) {
        f32x4 v[8]; u32x4 dl[4];
#pragma unroll
        for (int i = 0; i < 8; ++i) v[i] = nv[i];
#pragma unroll
        for (int i = 0; i < 4; ++i) dl[i] = nd[i];
        const int rn = r + stride;
        if (rn < nrows) LN_LOAD(rn);
        if (delta && !(part && r >= ROWS_LAT)) {
#pragma unroll
            for (int i = 0; i < 4; ++i) { v[2 * i] = ALPHA * v[2 * i] + (f32x4){bflo(dl[i].x), bfhi(dl[i].x), bflo(dl[i].y), bfhi(dl[i].y)}; v[2 * i + 1] = ALPHA * v[2 * i + 1] + (f32x4){bflo(dl[i].z), bfhi(dl[i].z), bflo(dl[i].w), bfhi(dl[i].w)}; }
        }
        if (part && r >= ROWS_LAT) {
            f32x4 a[8];
#pragma unroll
            for (int i = 0; i < 8; ++i) a[i] = pbias ? *(const f32x4*)(pbias + LN_C(i)) : (f32x4){0.f, 0.f, 0.f, 0.f};
#pragma unroll 1
            for (int k = 0; k < 8; ++k) { const float* pp = part + ((size_t)k * ROWS_CTX + (r - ROWS_LAT)) * D;
#pragma unroll
                for (int i = 0; i < 8; ++i) a[i] += *(const f32x4*)(pp + LN_C(i)); }
#pragma unroll
            for (int i = 0; i < 8; ++i) v[i] = ALPHA * v[i] + *(const f32x4*)(pgate + LN_C(i)) * a[i];
        }
        if (g) {
            float s = 0.f;
#pragma unroll
            for (int i = 0; i < 8; ++i) s += (v[i][0] + v[i][1]) + (v[i][2] + v[i][3]);
            const float mean = wave_sum(s) * (1.f / D); float q = 0.f;
#pragma unroll
            for (int i = 0; i < 8; ++i) { v[i] = v[i] - mean; q += (v[i][0] * v[i][0] + v[i][1] * v[i][1]) + (v[i][2] * v[i][2] + v[i][3] * v[i][3]); }
            const float rstd = 1.f / sqrtf(wave_sum(q) * (1.f / D) + 1e-6f);
            float* dst = r < ROWS_LAT ? (dst_lat ? dst_lat + (size_t)r * D : nullptr) : (dst_ctx ? dst_ctx + (size_t)(r - ROWS_LAT) * D : nullptr);
#pragma unroll
            for (int i = 0; i < 8; ++i) { const int c = LN_C(i); v[i] = v[i] * rstd * *(const f32x4*)(g + c) + *(const f32x4*)(b + c); if (dst) *(f32x4*)(dst + c) = v[i]; }
        }
        if (hout) {
            const int mr = r < ROWS_LAT ? (r >> 12) : 4;
            const float* sh = modl + ((size_t)mr * 6 + jsh) * D; const float* sc = modl + ((size_t)mr * 6 + jsc) * D;
            float s = 0.f;
#pragma unroll
            for (int i = 0; i < 8; ++i) s += (v[i][0] + v[i][1]) + (v[i][2] + v[i][3]);
            const float mean = wave_sum(s) * (1.f / D); float q = 0.f;
#pragma unroll
            for (int i = 0; i < 8; ++i) { v[i] = v[i] - mean; q += (v[i][0] * v[i][0] + v[i][1] * v[i][1]) + (v[i][2] * v[i][2] + v[i][3] * v[i][3]); }
            const float rstd = 1.f / sqrtf(wave_sum(q) * (1.f / D) + 1e-6f);
            bf16_t* hp = hout + (size_t)r * D;
#pragma unroll
            for (int i = 0; i < 4; ++i) { const int c = (lane + 64 * i) * 8;
                const f32x4 o0 = v[2 * i] * rstd * (1.f + *(const f32x4*)(sc + c)) + *(const f32x4*)(sh + c), o1 = v[2 * i + 1] * rstd * (1.f + *(const f32x4*)(sc + c + 4)) + *(const f32x4*)(sh + c + 4);
                u32x4 w; w.x = pk2(o0[0], o0[1]); w.y = pk2(o0[2], o0[3]); w.z = pk2(o1[0], o1[1]); w.w = pk2(o1[2], o1[3]); *(u32x4*)(hp + c) = w; }
        }
    }
#undef LN_LOAD
#undef LN_C
}
__device__ __forceinline__ void gla_prep(const Params& p, int l, LAS unsigned char* lds) {
    const int tid = opaque_tid(), lane = tid & 63, wave = __builtin_amdgcn_readfirstlane(tid >> 6), fr = lane & 15, fq = lane >> 4;
    LAS bf16_t* qts = (LAS bf16_t*)lds;
    LAS bf16_t* kts = (LAS bf16_t*)(lds + 17408);
    LAS bf16_t* khs = (LAS bf16_t*)(lds + 34816);
    LAS bf16_t* ps = (LAS bf16_t*)(lds + 53248);
    LAS float* lrs = (LAS float*)(lds + 62464);
    LAS float* gts = (LAS float*)(lds + 66560);
    unsigned char* C = p.ws + OFF_C;
    const bf16_t* pq = (const bf16_t*)(C + C_PQ); const bf16_t* pk = (const bf16_t*)(C + C_PK); const float* lr = (const float*)(C + C_LR);
    const int d = tid & 127, mg = tid >> 7;
    f32x4 nlr = {0.f, 0.f, 0.f, 0.f}; float nwu[16], nbg = 0.f; unsigned short nq[16], nk[16];
#define PREP_LOAD(item_) do { const int chain_ = (item_) / 68, mc_ = (item_) % 68, b_ = chain_ >> 3, h_ = (chain_ >> 1) & 3, dir_ = chain_ & 1; \
        const int rb_ = mc_ < 4 ? ROWS_LAT + b_ * CTXL + mc_ * 64 : b_ * T + (mc_ - 4) * 64; \
        if (tid < 256) nlr = *(const f32x4*)(lr + (size_t)(rb_ + (tid >> 2)) * 32 + dir_ * 16 + (tid & 3) * 4); \
        _Pragma("unroll") for (int r = 0; r < 16; ++r) nwu[r] = p.w_gate_up[((size_t)(l * 2 + dir_) * 16 + r) * 512 + h_ * 128 + d]; \
        nbg = p.b_gate[(size_t)(l * 2 + dir_) * 512 + h_ * 128 + d]; \
        _Pragma("unroll") for (int j = 0; j < 16; ++j) { nq[j] = pq[(size_t)(rb_ + mg * 16 + j) * 512 + h_ * 128 + d]; nk[j] = pk[(size_t)(rb_ + mg * 16 + j) * 512 + h_ * 128 + d]; } } while (0)
    if ((int)blockIdx.x < 2176) PREP_LOAD((int)blockIdx.x);
    for (int item = blockIdx.x; item < 2176; item += gridDim.x) {
        const int chain = item / 68, mc = item % 68, dir = chain & 1;
        if (tid < 256) *(LAS f32x4*)(lrs + (tid >> 2) * 16 + (tid & 3) * 4) = nlr;
        float wu[16]; unsigned short cq[16], ck[16];
#pragma unroll
        for (int r = 0; r < 16; ++r) { wu[r] = nwu[r]; cq[r] = nq[r]; ck[r] = nk[r]; }
        const float bg = nbg;
        __syncthreads();
        if (item + (int)gridDim.x < 2176) PREP_LOAD(item + (int)gridDim.x);
        float la[16];
#pragma unroll
        for (int j = 0; j < 16; ++j) { const int m = mg * 16 + j; float z = bg;
#pragma unroll
            for (int r4 = 0; r4 < 4; ++r4) { const f32x4 x = *(const LAS f32x4*)(lrs + m * 16 + r4 * 4); z += x[0] * wu[r4 * 4] + x[1] * wu[r4 * 4 + 1] + x[2] * wu[r4 * 4 + 2] + x[3] * wu[r4 * 4 + 3]; }
            la[j] = (fminf(z, 0.f) - __logf(1.f + __expf(-fabsf(z)))) * (1.f / 16.f); }
        if (dir == 0) {
#pragma unroll
            for (int j = 1; j < 16; ++j) la[j] += la[j - 1];
        } else {
#pragma unroll
            for (int j = 14; j >= 0; --j) la[j] += la[j + 1];
        }
        gts[mg * 128 + d] = dir == 0 ? la[15] : la[0];
        __syncthreads();
        const float g0 = gts[d], g1 = gts[128 + d], g2 = gts[256 + d], g3 = gts[384 + d];
        const float total = (g0 + g1) + (g2 + g3);
        float off = 0.f;
        if (dir == 0) { if (mg > 0) off += g0; if (mg > 1) off += g1; if (mg > 2) off += g2; } else { if (mg < 3) off += g3; if (mg < 2) off += g2; if (mg < 1) off += g1; }
        float kh[16];
#pragma unroll
        for (int j = 0; j < 16; ++j) { const int m = mg * 16 + j; const float cum = fmaxf(la[j] + off, -80.f);
            const float qv = __uint_as_float(((unsigned)cq[j]) << 16), kv = __uint_as_float(((unsigned)ck[j]) << 16);
            qts[m * 136 + d] = bf1(qv * QSCALE * __expf(cum)); kts[m * 136 + d] = bf1(kv * __expf(-cum)); kh[j] = kv * __expf(total - cum); }
        { u32x4 w0, w1;
          w0.x = pk2(kh[0], kh[1]); w0.y = pk2(kh[2], kh[3]); w0.z = pk2(kh[4], kh[5]); w0.w = pk2(kh[6], kh[7]);
          w1.x = pk2(kh[8], kh[9]); w1.y = pk2(kh[10], kh[11]); w1.z = pk2(kh[12], kh[13]); w1.w = pk2(kh[14], kh[15]);
          *(LAS u32x4*)(khs + d * 72 + mg * 16) = w0; *(LAS u32x4*)(khs + d * 72 + mg * 16 + 8) = w1; }
        if (mg == 0) ((float*)(C + C_E))[(size_t)item * 128 + d] = __expf(total);
        __syncthreads();
#pragma unroll
        for (int tt = 0; tt < 2; ++tt) { const int tile = wave * 2 + tt, it = tile >> 2, jt = tile & 3; f32x4 acc = {0.f, 0.f, 0.f, 0.f};
#pragma unroll
            for (int ks = 0; ks < 4; ++ks) { const bf16x8 a = *(const LAS bf16x8*)(qts + (it * 16 + fr) * 136 + ks * 32 + fq * 8), bb = *(const LAS bf16x8*)(kts + (jt * 16 + fr) * 136 + ks * 32 + fq * 8);
                acc = __builtin_amdgcn_mfma_f32_16x16x32_bf16(a, bb, acc, 0, 0, 0); }
#pragma unroll
            for (int jj = 0; jj < 4; ++jj) { const int i = it * 16 + fq * 4 + jj, jc = jt * 16 + fr; const bool keep = dir == 0 ? (jc <= i) : (jc >= i); ps[i * 72 + jc] = bf1(keep ? acc[jj] : 0.f); } }
        __syncthreads();
        bf16_t* qo = (bf16_t*)(C + C_QT) + (size_t)item * 8192; bf16_t* ko = (bf16_t*)(C + C_KHT) + (size_t)item * 8192; bf16_t* po = (bf16_t*)(C + C_P) + (size_t)item * 4096;
#pragma unroll
        for (int k = 0; k < 2; ++k) { const int q = tid + 512 * k; *(u32x4*)(qo + (q >> 4) * 128 + (q & 15) * 8) = *(const LAS u32x4*)(qts + (q >> 4) * 136 + (q & 15) * 8);
            *(u32x4*)(ko + (q >> 3) * 64 + (q & 7) * 8) = *(const LAS u32x4*)(khs + (q >> 3) * 72 + (q & 7) * 8); }
        *(u32x4*)(po + (tid >> 3) * 64 + (tid & 7) * 8) = *(const LAS u32x4*)(ps + (tid >> 3) * 72 + (tid & 7) * 8);
        __syncthreads();
    }
#undef PREP_LOAD
}
constexpr int CH_BUF = 54784, CH_KH = 17408, CH_P = 35840, CH_V = 45056, CH_E = 54272, CH_ST = 2 * CH_BUF;
__device__ __forceinline__ void gla_chain(const Params& p, LAS unsigned char* lds) {
    if (blockIdx.x >= 128) return;
    const int tid = opaque_tid(), lane = tid & 63, wave = __builtin_amdgcn_readfirstlane(tid >> 6), fr = lane & 15, fq = lane >> 4;
    const int chain = blockIdx.x & 31, vg = blockIdx.x >> 5, b = chain >> 3, h = (chain >> 1) & 3, dir = chain & 1;
    unsigned char* C = p.ws + OFF_C;
    const bf16_t* QTg = (const bf16_t*)(C + C_QT) + (size_t)chain * 68 * 8192; const bf16_t* KHg = (const bf16_t*)(C + C_KHT) + (size_t)chain * 68 * 8192;
    const bf16_t* Pg = (const bf16_t*)(C + C_P) + (size_t)chain * 68 * 4096; const float* Eg = (const float*)(C + C_E) + (size_t)chain * 68 * 128;
    const bf16_t* vtl = (const bf16_t*)(C + C_VTL) + ((size_t)b * 1024 + h * 256 + vg * 64 + (tid >> 3)) * T + (tid & 7) * 8;
    const bf16_t* vtc = (const bf16_t*)(C + C_VTC) + ((size_t)b * 1024 + h * 256 + vg * 64 + (tid >> 3)) * CTXL + (tid & 7) * 8;
    bf16_t* Og = (bf16_t*)(C + (dir ? C_OB : C_OF)) + h * 256 + vg * 64 + (wave & 3) * 16 + fq * 4;
    LAS unsigned char* st = lds + CH_ST + (wave & 3) * 4352;
    u32x4 ra0, ra1, ra2, ra3, ra4, ra5, rb0, rb1, rb2, rb3, rb4, rb5; f32x4 rae = {0.f, 0.f, 0.f, 0.f}, rbe = {0.f, 0.f, 0.f, 0.f};
#define CH_ISSUE_(ci, r0, r1, r2, r3, r4, r5, re) do { const int ci_ = (ci) < 68 ? (ci) : 67; const int mc_ = dir == 0 ? ci_ : (ci_ < 4 ? 3 - ci_ : 71 - ci_); \
        r0 = *(const u32x4*)(QTg + (size_t)mc_ * 8192 + (tid >> 4) * 128 + (tid & 15) * 8); r1 = *(const u32x4*)(QTg + (size_t)mc_ * 8192 + ((tid >> 4) + 32) * 128 + (tid & 15) * 8); \
        r2 = *(const u32x4*)(KHg + (size_t)mc_ * 8192 + (tid >> 3) * 64 + (tid & 7) * 8); r3 = *(const u32x4*)(KHg + (size_t)mc_ * 8192 + ((tid >> 3) + 64) * 64 + (tid & 7) * 8); \
        r4 = *(const u32x4*)(Pg + (size_t)mc_ * 4096 + (tid >> 3) * 64 + (tid & 7) * 8); \
        r5 = mc_ < 4 ? *(const u32x4*)(vtc + mc_ * 64) : *(const u32x4*)(vtl + (mc_ - 4) * 64); \
        re = *(const f32x4*)(Eg + (size_t)mc_ * 128 + (tid & 31) * 4); } while (0)
#define CH_WRITE_(buf, r0, r1, r2, r3, r4, r5, re) do { LAS unsigned char* b_ = lds + (buf) * CH_BUF; \
        *(LAS u32x4*)(b_ + (tid >> 4) * 272 + (tid & 15) * 16) = r0; *(LAS u32x4*)(b_ + ((tid >> 4) + 32) * 272 + (tid & 15) * 16) = r1; \
        *(LAS u32x4*)(b_ + CH_KH + (tid >> 3) * 144 + (tid & 7) * 16) = r2; *(LAS u32x4*)(b_ + CH_KH + ((tid >> 3) + 64) * 144 + (tid & 7) * 16) = r3; \
        *(LAS u32x4*)(b_ + CH_P + (tid >> 3) * 144 + (tid & 7) * 16) = r4; *(LAS u32x4*)(b_ + CH_V + (tid >> 3) * 144 + (tid & 7) * 16) = r5; \
        if (tid < 32) *(LAS f32x4*)(b_ + CH_E + tid * 16) = re; } while (0)
#define SET_A ra0, ra1, ra2, ra3, ra4, ra5, rae
#define SET_B rb0, rb1, rb2, rb3, rb4, rb5, rbe
#define CH_ISSUE(ci, set) CH_ISSUE_X(ci, set)
#define CH_ISSUE_X(ci, ...) CH_ISSUE_(ci, __VA_ARGS__)
#define CH_WRITE(buf, set) CH_WRITE_X(buf, set)
#define CH_WRITE_X(buf, ...) CH_WRITE_(buf, __VA_ARGS__)
    CH_ISSUE(0, SET_A); CH_WRITE(0, SET_A); CH_ISSUE(1, SET_B);
    f32x4 S[8];
#pragma unroll
    for (int dt = 0; dt < 8; ++dt) S[dt] = (f32x4){0.f, 0.f, 0.f, 0.f};
    if (wave < 4) {
#pragma unroll
        for (int dt = 0; dt < 8; ++dt) *(LAS u32x2*)(st + fr * 272 + (dt * 16 + fq * 4) * 2) = (u32x2){0u, 0u};
    }
    __syncthreads();
    auto step = [&](const int ci, LAS unsigned char* cur) {
        const int w4 = wave & 3;
        bf16x8 a_v[2];
#pragma unroll
        for (int ks = 0; ks < 2; ++ks) a_v[ks] = *(const LAS bf16x8*)(cur + CH_V + (w4 * 16 + fr) * 144 + ks * 64 + fq * 16);
        if (wave >= 4) {
            const int mc = dir == 0 ? ci : (ci < 4 ? 3 - ci : 71 - ci);
            const int rb = mc < 4 ? ROWS_LAT + b * CTXL + mc * 64 : b * T + (mc - 4) * 64;
            const LAS unsigned char* sti = st + (ci & 1) * (4 * 4352);
            bf16x8 a_st[4];
#pragma unroll
            for (int ks = 0; ks < 4; ++ks) a_st[ks] = *(const LAS bf16x8*)(sti + fr * 272 + ks * 64 + fq * 16);
#pragma unroll
            for (int ih = 0; ih < 2; ++ih) {
                bf16x8 bq[2][4], bp[2][2]; f32x4 o[2];
#pragma unroll
                for (int i2 = 0; i2 < 2; ++i2) { const int it = ih * 2 + i2; o[i2] = (f32x4){0.f, 0.f, 0.f, 0.f};
#pragma unroll
                    for (int ks = 0; ks < 4; ++ks) bq[i2][ks] = *(const LAS bf16x8*)(cur + (it * 16 + fr) * 272 + ks * 64 + fq * 16);
#pragma unroll
                    for (int ks = 0; ks < 2; ++ks) bp[i2][ks] = *(const LAS bf16x8*)(cur + CH_P + (it * 16 + fr) * 144 + ks * 64 + fq * 16); }
#pragma unroll
                for (int ks = 0; ks < 4; ++ks)
#pragma unroll
                    for (int i2 = 0; i2 < 2; ++i2) o[i2] = __builtin_amdgcn_mfma_f32_16x16x32_bf16(a_st[ks], bq[i2][ks], o[i2], 0, 0, 0);
#pragma unroll
                for (int ks = 0; ks < 2; ++ks)
#pragma unroll
                    for (int i2 = 0; i2 < 2; ++i2) o[i2] = __builtin_amdgcn_mfma_f32_16x16x32_bf16(a_v[ks], bp[i2][ks], o[i2], 0, 0, 0);
#pragma unroll
                for (int i2 = 0; i2 < 2; ++i2) { u32x2 ow; ow.x = pk2(o[i2][0], o[i2][1]); ow.y = pk2(o[i2][2], o[i2][3]); *(u32x2*)(Og + (size_t)(rb + (ih * 2 + i2) * 16 + fr) * 1024) = ow; }
            }
        } else {
            LAS unsigned char* sto = st + ((ci + 1) & 1) * (4 * 4352);
#pragma unroll
            for (int hh = 0; hh < 2; ++hh) {
                f32x4 ev[4]; bf16x8 ak[4][2];
#pragma unroll
                for (int d4 = 0; d4 < 4; ++d4) { const int dt = hh * 4 + d4; ev[d4] = *(const LAS f32x4*)(cur + CH_E + (dt * 16 + fq * 4) * 4);
#pragma unroll
                    for (int ks = 0; ks < 2; ++ks) ak[d4][ks] = *(const LAS bf16x8*)(cur + CH_KH + (dt * 16 + fr) * 144 + ks * 64 + fq * 16); }
#pragma unroll
                for (int d4 = 0; d4 < 4; ++d4) S[hh * 4 + d4] = S[hh * 4 + d4] * ev[d4];
#pragma unroll
                for (int ks = 0; ks < 2; ++ks)
#pragma unroll
                    for (int d4 = 0; d4 < 4; ++d4) S[hh * 4 + d4] = __builtin_amdgcn_mfma_f32_16x16x32_bf16(ak[d4][ks], a_v[ks], S[hh * 4 + d4], 0, 0, 0);
            }
#pragma unroll
            for (int dt = 0; dt < 8; ++dt) { u32x2 w2; w2.x = pk2(S[dt][0], S[dt][1]); w2.y = pk2(S[dt][2], S[dt][3]); *(LAS u32x2*)(sto + fr * 272 + (dt * 16 + fq * 4) * 2) = w2; }
        }
    };
    for (int ci = 0; ci < 68; ci += 2) {
        CH_ISSUE(ci + 2, SET_A);
        step(ci, lds);
        CH_WRITE(1, SET_B);
        __syncthreads();
        CH_ISSUE(ci + 3, SET_B);
        step(ci + 1, lds + CH_BUF);
        CH_WRITE(0, SET_A);
        __syncthreads();
    }
#undef SET_A
#undef SET_B
#undef CH_ISSUE_
#undef CH_WRITE_
#undef CH_ISSUE_X
#undef CH_WRITE_X
#undef CH_ISSUE
#undef CH_WRITE
}
__device__ __forceinline__ void mix_phase(const Params& p, int l, int nrows) {
    const int tid_ = opaque_tid(), lane = tid_ & 63, wave = tid_ >> 6;
    unsigned char* C = p.ws + OFF_C;
    const bf16_t* of = (const bf16_t*)(C + C_OF); const bf16_t* ob = (const bf16_t*)(C + C_OB);
    const bf16_t* pg = (const bf16_t*)(C + C_PG); const bf16_t* pu = (const bf16_t*)(C + C_PU);
    bf16_t* mixed = (bf16_t*)(p.ws + OFF_H);
    const f32x4 ng = *(const f32x4*)(p.gla_norm_g + l * 256 + lane * 4);
    const int stride = gridDim.x * 8;
    int r = blockIdx.x * 8 + wave;
    u32x2 nof[4], nob[4]; u32x2 ngw[4];
#define MIX_LOAD(rr) do { _Pragma("unroll") for (int h = 0; h < 4; ++h) { const size_t o4_ = (size_t)(rr) * 1024 + h * 256 + lane * 4; nof[h] = *(const u32x2*)(of + o4_); nob[h] = *(const u32x2*)(ob + o4_); ngw[h] = *(const u32x2*)(pg + o4_); } } while (0)
    if (r < nrows) MIX_LOAD(r);
    for (; r < nrows; r += stride) {
        u32x2 cof[4], cob[4]; u32x2 cgw[4];
#pragma unroll
        for (int h = 0; h < 4; ++h) { cof[h] = nof[h]; cob[h] = nob[h]; cgw[h] = ngw[h]; }
        int t, seg0, seg1, r0;
        if (r < ROWS_LAT) { t = r & (T - 1); r0 = r - t; seg0 = t & ~63; seg1 = seg0 + 63; } else { t = (r - ROWS_LAT) & (CTXL - 1); r0 = r - t; seg0 = 0; seg1 = CTXL - 1; }
        u32x4 pw0[4], pw1[16], uc[2];
#pragma unroll
        for (int k = 0; k < 4; ++k) { const int tc = min(max(t - 2 + k, seg0), seg1); pw0[k] = *(const u32x4*)(pu + (size_t)(r0 + tc) * 1024 + lane * 8); }
#pragma unroll
        for (int k = 0; k < 16; ++k) { const int tc = min(max(t - 8 + k, seg0), seg1); pw1[k] = *(const u32x4*)(pu + (size_t)(r0 + tc) * 1024 + 512 + lane * 8); }
#pragma unroll
        for (int it = 0; it < 2; ++it) uc[it] = *(const u32x4*)(pu + (size_t)r * 1024 + it * 512 + lane * 8);
        { const int rn = min(r + stride, nrows - 1); MIX_LOAD(rn); }
#pragma unroll
        for (int h = 0; h < 4; ++h) {
            const f32x4 o = (f32x4){bflo(cof[h].x) + bflo(cob[h].x), bfhi(cof[h].x) + bfhi(cob[h].x), bflo(cof[h].y) + bflo(cob[h].y), bfhi(cof[h].y) + bfhi(cob[h].y)};
            const float ss = wave_sum((o[0] * o[0] + o[1] * o[1]) + (o[2] * o[2] + o[3] * o[3]));
            const float rinv = 1.f / sqrtf(ss * (1.f / 256.f) + 1e-6f);
            const u32x2 gw = cgw[h];
            const f32x4 y = o * rinv * ng;
            u32x2 w; w.x = pk2(y[0] * siluf(bflo(gw.x)), y[1] * siluf(bfhi(gw.x))); w.y = pk2(y[2] * siluf(bflo(gw.y)), y[3] * siluf(bfhi(gw.y)));
            *(u32x2*)(mixed + (size_t)r * D + h * 256 + lane * 4) = w;
        }
#pragma unroll
        for (int it = 0; it < 2; ++it) {
            const int c = it * 512 + lane * 8, gi = c >> 8, hw = 1 << gi;
            const int lo = max(t - hw, seg0), hi = min(t + hw - 1, seg1);
            const int kmax = it == 0 ? 4 : 16, tb = t - kmax / 2;
            float s[8];
#pragma unroll
            for (int j = 0; j < 8; ++j) s[j] = 0.f;
#pragma unroll
            for (int k = 0; k < kmax; ++k) { const int tt = tb + k; const bool ok = tt >= lo && tt <= hi;
                u32x4 uw = it == 0 ? pw0[k & 3] : pw1[k];
                if (!ok) uw = (u32x4){0u, 0u, 0u, 0u};
                s[0] += bflo(uw.x); s[1] += bfhi(uw.x); s[2] += bflo(uw.y); s[3] += bfhi(uw.y); s[4] += bflo(uw.z); s[5] += bfhi(uw.z); s[6] += bflo(uw.w); s[7] += bfhi(uw.w); }
            const float inv = 1.f / (float)(hi - lo + 1);
            const u32x4 ucv = uc[it];
            u32x4 w; w.x = pk2(s[0] * inv - bflo(ucv.x), s[1] * inv - bfhi(ucv.x)); w.y = pk2(s[2] * inv - bflo(ucv.y), s[3] * inv - bfhi(ucv.y));
            w.z = pk2(s[4] * inv - bflo(ucv.z), s[5] * inv - bfhi(ucv.z)); w.w = pk2(s[6] * inv - bflo(ucv.w), s[7] * inv - bfhi(ucv.w));
            *(u32x4*)(mixed + (size_t)r * D + 1024 + c) = w;
        }
    }
#undef MIX_LOAD
}


#define XB_TMO      128
#define XB_XCNT(j)  (256  + 64 * (j))
#define XB_XSUB(j)  (1280 + 64 * (j))
#define XB_XGEN(j)  (2304 + 64 * (j))
#define XB_TOP      3328
#define XB_TOPGEN   3392
#define XCD_BAR_WORDS 3456
#define XB_SPIN_CAP (1u << 18)
__device__ __forceinline__ unsigned xb_ld(unsigned* p)              { return __hip_atomic_load(p, __ATOMIC_RELAXED, __HIP_MEMORY_SCOPE_AGENT); }
__device__ __forceinline__ unsigned xb_add(unsigned* p, unsigned v) { return __hip_atomic_fetch_add(p, v, __ATOMIC_RELAXED, __HIP_MEMORY_SCOPE_AGENT); }
__device__ __forceinline__ unsigned xb_xcc_id() { return (unsigned)__builtin_amdgcn_s_getreg((3 << 11) | 20) & 0xFu; }
#define XB_SPIN(cond, bar) do { unsigned _sp = 0; while (cond) { __builtin_amdgcn_s_sleep(1); \
    if ((++_sp & 255u) == 0u) { if (xb_ld(&(bar)[XB_TMO])) break; if (_sp > XB_SPIN_CAP) { atomicAdd(&(bar)[XB_TMO], 1u); break; } } } } while (0)
struct XcdBarrier { unsigned* bar; unsigned x; volatile LAS unsigned* st; };
__device__ __forceinline__ void xcd_barrier_complete(unsigned* bar, unsigned x, unsigned& nloc, unsigned& nx) {
    const unsigned G = gridDim.x * gridDim.y * gridDim.z;
    unsigned sum, cnt, mine, sp = 0u;
    for (;;) {
        sum = 0u; cnt = 0u; mine = 0u;
#pragma unroll
        for (unsigned j = 0; j < 16; ++j) { const unsigned c = xb_ld(&bar[XB_XCNT(j)]); sum += c; cnt += (c > 0u) ? 1u : 0u; mine = (j == x) ? c : mine; }
        if (sum == G) break;
        __builtin_amdgcn_s_sleep(1);
        if ((++sp & 255u) == 0u) { if (xb_ld(&bar[XB_TMO])) break; if (sp > XB_SPIN_CAP) { atomicAdd(&bar[XB_TMO], 1u); break; } }
    }
    nloc = mine > 0u ? mine : 1u; nx = cnt > 0u ? cnt : 1u;
}
__device__ __forceinline__ void xcd_barrier(const XcdBarrier& b) {
    asm volatile("s_waitcnt vmcnt(0)" ::: "memory");
    __syncthreads();
    if (threadIdx.x == 0) {
        unsigned* bar = b.bar;
        __builtin_amdgcn_s_waitcnt(0);
        unsigned nloc = b.st[0], nx = b.st[1];
        if (nloc == 0u) { xcd_barrier_complete(bar, b.x, nloc, nx); b.st[0] = nloc; b.st[1] = nx; }
        const unsigned old = xb_add(&bar[XB_XSUB(b.x)], 1u);
        const unsigned gen = old / nloc;
        if (old + 1u == (gen + 1u) * nloc) {
            __builtin_amdgcn_fence(__ATOMIC_RELEASE, "agent");
            asm volatile("s_waitcnt vmcnt(0)" ::: "memory");
            const unsigned og = xb_add(&bar[XB_TOP], 1u);
            const unsigned tg = og / nx;
            if (og + 1u == (tg + 1u) * nx) xb_add(&bar[XB_TOPGEN], 1u);
            else XB_SPIN(xb_ld(&bar[XB_TOPGEN]) == tg, bar);
            __builtin_amdgcn_fence(__ATOMIC_ACQUIRE, "agent");
            xb_add(&bar[XB_XGEN(b.x)], 1u);
            asm volatile("s_waitcnt vmcnt(0)" ::: "memory");
        } else {
            XB_SPIN(xb_ld(&bar[XB_XGEN(b.x)]) == gen, bar);
            __builtin_amdgcn_fence(__ATOMIC_ACQUIRE, "agent");
            asm volatile("s_waitcnt vmcnt(0)" ::: "memory");
        }
    }
    __syncthreads();
}

typedef const __attribute__((address_space(4))) Params KParams;
#if defined(__HIP_DEVICE_COMPILE__)
__device__ __forceinline__ Params load_params() { KParams* kp = (KParams*)__builtin_amdgcn_kernarg_segment_ptr(); asm volatile("" : "+s"(kp)); return *kp; }
#else
__device__ Params load_params();
#endif
#ifndef PHASE_MASK
#define PHASE_MASK 0xFFFF
#endif
#ifndef DUP_MASK
#define DUP_MASK 0
#endif
#define PH(i) if (PHASE_MASK & (1 << (i))) for (int dup_ = 0; dup_ <= ((DUP_MASK >> (i)) & 1); ++dup_)
__global__ void __launch_bounds__(512, 2) mega(Params p_unused) {
    extern __shared__ __attribute__((aligned(16))) unsigned char shm[];
    cg::grid_group grid = cg::this_grid();
    LAS unsigned char* lds = (LAS unsigned char*)shm;
    LAS float* ldsf = (LAS float*)shm;
    const int G = gridDim.x, bid = blockIdx.x;
#define WSP(off) (p.ws + (off))
    volatile LAS unsigned* xst = (volatile LAS unsigned*)(lds + 144384);
    if (threadIdx.x < 4) xst[threadIdx.x] = 0u;
    __syncthreads();
    { const Params p = load_params(); if (threadIdx.x == 0) (void)xb_add(&((unsigned*)WSP(OFF_BAR))[XB_XCNT(xb_xcc_id())], 1u); }
#define GSYNC() do { const Params pb_ = load_params(); XcdBarrier xb_; xb_.bar = (unsigned*)(pb_.ws + OFF_BAR); xb_.x = xb_xcc_id(); xb_.st = xst; xcd_barrier(xb_); } while (0)
#define CP(off) (p.ws + OFF_C + (off))

    PH(0) { const Params p = load_params();
      for (int it = bid; it < 192; it += G) modp_task(p, 0, it, ldsf);
      convert_phase(p, 0, ldsf, 0, 4352, 0, G); }
    if (gridDim.x == 0x7fffffffu) grid.sync();
    GSYNC();
    PH(1) { const Params p = load_params(); const float* modp = (const float*)WSP(OFF_MODP); float* MOD = (float*)WSP(OFF_MOD);
      for (int i = bid * 512 + threadIdx.x; i < 5 * 12288; i += G * 512) { const int n = i % 12288; float s = p.b_ada[n];
#pragma unroll 8
          for (int k = 0; k < 32; ++k) s += modp[(size_t)k * (2 * 5 * 12288) + i];
          MOD[i] = s; } }
    GSYNC();
    PH(2) { const Params p = load_params(); ln_phase(ROWS, p.x, p.ctx, nullptr, nullptr, nullptr, nullptr, (const float*)WSP(OFF_MOD), 0, 1, (bf16_t*)WSP(OFF_H)); }
    GSYNC();

    for (int l = 0; l < 2; ++l) {
        const int nrows = l == 0 ? ROWS : ROWS_LAT;
        PH(3) { const Params p = load_params(); pg8::StaticOrder S;
          pg8::Gemm g{(const bf16_t*)WSP(OFF_H), (const bf16_t*)WSP(OFF_W), ROWS, NIN, D, D, D, 0}; S.init(g.M, g.N, opaque_s(G), opaque_s(bid));
          EpiIn e{(bf16_t*)CP(C_PK), (bf16_t*)CP(C_VTL), (bf16_t*)CP(C_VTC), (bf16_t*)CP(C_PQ), (bf16_t*)CP(C_PG), (bf16_t*)CP(C_PU), (float*)CP(C_LR)};
          pg8::gemm_phase(lds, g, S, e);
          if (bid >= 132) { convert_phase(p, l, ldsf, 4352, l == 0 ? CVT_SPLIT : CVT_SPLIT - 2000, 132, G - 132); convert_phase(p, l, ldsf, CVT_ITEMS - 128, CVT_ITEMS, 132, G - 132); } }
        GSYNC();
        PH(4) { const Params p = load_params(); gla_prep(p, l, lds); }
        GSYNC();
        PH(12) { const Params p = load_params(); gla_chain(p, lds);
          if (bid >= 128) {
            if (bid < 160) {
              pg8::StaticOrder S; bf16_t* wo = (bf16_t*)WSP(OFF_W) + NW_IN;
              pg8::Gemm g{wo + 1024, (const bf16_t*)WSP(OFF_W) + NW_IN + NW_OUT + NW_1 + NW_2, D, 1024, 256, D, 256, 512}; S.init(g.M, g.N, 32, opaque_s(bid - 128));
              EpiPool e{wo, nullptr};
              pg8::gemm_phase(lds, g, S, e); }
            convert_phase(p, l, ldsf, l == 0 ? CVT_SPLIT : CVT_SPLIT - 2000, CVT_ITEMS - 128, 128, G - 128);
            if (l == 0 && bid >= 160) { __syncthreads(); for (int it = bid - 160; it < 192; it += G - 160) modp_task(p, 1, it, ldsf); } } }
        GSYNC();
        PH(5) { const Params p = load_params(); mix_phase(p, l, nrows);
          if (l == 0) { const float* modp = (const float*)WSP(OFF_MODP) + 5 * 12288; float* MOD1 = (float*)WSP(OFF_MOD) + 5 * 12288;
            for (int i = bid * 512 + threadIdx.x; i < 5 * 12288; i += G * 512) { float sacc = p.b_ada[12288 + i % 12288];
#pragma unroll 8
              for (int k = 0; k < 32; ++k) sacc += modp[(size_t)k * (2 * 5 * 12288) + i];
              MOD1[i] = sacc; } } }
        GSYNC();
        PH(7) { const Params p = load_params(); pg8::StaticOrder S;
          pg8::Gemm g{(const bf16_t*)WSP(OFF_H), (const bf16_t*)WSP(OFF_W) + NW_IN, nrows, D, D, D, D, 0};
          if (l == 0) S.init_split(ROWS_LAT, g.N, opaque_s(G), opaque_s(bid), 4, 8); else S.init(g.M, g.N, opaque_s(G), opaque_s(bid));
          EpiDelta e{(bf16_t*)CP(C_PK), (const float*)WSP(OFF_MOD) + (size_t)l * 5 * 12288 + 2 * D, nullptr, (float*)CP(C_PART2)};
          pg8::gemm_phase(lds, g, S, e); }
        GSYNC();
        PH(8) { const Params p = load_params(); float* XB = (float*)WSP(OFF_XB);
          const float* modl = (const float*)WSP(OFF_MOD) + (size_t)l * 5 * 12288;
          ln_phase(nrows, l == 0 ? p.x : XB, l == 0 ? p.ctx : XB + (size_t)ROWS_LAT * D, p.ln1_g + l * D, p.ln1_b + l * D, XB, XB + (size_t)ROWS_LAT * D, modl, 3, 4, (bf16_t*)WSP(OFF_H),
                   (const bf16_t*)CP(C_PK), l == 0 ? (const float*)CP(C_PART2) : nullptr, modl + (4 * 6 + 2) * D, nullptr); }
        GSYNC();
        PH(9) { const Params p = load_params(); pg8::StaticOrder S;
          pg8::Gemm g{(const bf16_t*)WSP(OFF_H), (const bf16_t*)WSP(OFF_W) + NW_IN + NW_OUT, nrows, DFF, D, D, D, 0}; S.init(g.M, g.N, opaque_s(G), opaque_s(bid));
          EpiMlp1 e{(bf16_t*)CP(C_A1), p.b_mlp1 + l * DFF};
          pg8::gemm_phase(lds, g, S, e);
          if (l == 0 && bid >= 128) convert_phase(p, 1, ldsf, 0, 4352, 128, G - 128); }
        GSYNC();
        PH(10) { const Params p = load_params(); pg8::StaticOrder S;
          pg8::Gemm g{(const bf16_t*)CP(C_A1), (const bf16_t*)WSP(OFF_W) + NW_IN + NW_OUT + NW_1, nrows, D, DFF, DFF, DFF, 0};
          if (l == 0) S.init_split(ROWS_LAT, g.N, opaque_s(G), opaque_s(bid), 4, 8); else S.init(g.M, g.N, opaque_s(G), opaque_s(bid));
          EpiDelta e{(bf16_t*)WSP(OFF_H), (const float*)WSP(OFF_MOD) + (size_t)l * 5 * 12288 + 5 * D, p.b_mlp2 + l * D, (float*)CP(C_PART4)};
          pg8::gemm_phase(lds, g, S, e); }
        GSYNC();
        PH(11) { const Params p = load_params(); float* XB = (float*)WSP(OFF_XB);
          if (l == 0) {
            ln_phase(ROWS, XB, XB + (size_t)ROWS_LAT * D, p.ln2_g, p.ln2_b, XB, XB + (size_t)ROWS_LAT * D, (const float*)WSP(OFF_MOD) + (size_t)5 * 12288, 0, 1, (bf16_t*)WSP(OFF_H),
                     (const bf16_t*)WSP(OFF_H), (const float*)CP(C_PART4), (const float*)WSP(OFF_MOD) + (4 * 6 + 5) * D, p.b_mlp2);
          } else {
            ln_phase(ROWS_LAT, XB, nullptr, p.ln2_g + D, p.ln2_b + D, p.out, nullptr, nullptr, 0, 0, nullptr, (const bf16_t*)WSP(OFF_H));
          } }
        if (l == 0) GSYNC();
    }
}

extern "C" void kernel_launch(void* const* d_in, const int* in_sizes, int n_in, void* d_out, int out_size, void* d_ws, size_t ws_size, hipStream_t stream) {
    constexpr int LDS_BYTES = 144384 + 16;
    static int grid = 0;
    if (grid == 0) {
        if (n_in != 21 || ws_size < WS_NEED) { fprintf(stderr, "kernel_launch: need 21 inputs and %zu bytes of workspace; got %d, %zu\n", (size_t)WS_NEED, n_in, ws_size); grid = -1; return; }
        int dev = 0, cus = 0, per_cu = 0;
        hipGetDevice(&dev); hipDeviceGetAttribute(&cus, hipDeviceAttributeMultiprocessorCount, dev);
        if (hipFuncSetAttribute((const void*)mega, hipFuncAttributeMaxDynamicSharedMemorySize, LDS_BYTES) != hipSuccess) { fprintf(stderr, "kernel_launch: hipFuncSetAttribute failed\n"); grid = -1; return; }
        if (hipOccupancyMaxActiveBlocksPerMultiprocessor(&per_cu, (const void*)mega, 512, LDS_BYTES) != hipSuccess || per_cu < 1) { fprintf(stderr, "kernel_launch: occupancy query gave %d\n", per_cu); per_cu = 1; }
        (void)hipGetLastError();
        grid = cus * 1;
        fprintf(stderr, "kernel_launch: grid %d (per_cu %d)\n", grid, per_cu);
    }
    if (grid < 0) return;
    if (hipMemsetAsync((unsigned char*)d_ws + OFF_BAR, 0, 16384, stream) != hipSuccess) { fprintf(stderr, "kernel_launch: memset failed\n"); return; }
    Params p{};
    const float** pp = (const float**)&p;
    for (int i = 0; i < 21; ++i) pp[i] = (const float*)d_in[i];
    p.out = (float*)d_out; p.ws = (unsigned char*)d_ws;
    void* args[] = {&p};
    hipError_t e = hipLaunchCooperativeKernel((const void*)mega, dim3(grid), dim3(512), args, LDS_BYTES, stream);
    if (e != hipSuccess) fprintf(stderr, "kernel_launch: cooperative launch failed: %s (grid %d)\n", hipGetErrorString(e), grid);
}
```

```cpp
#include <hip/hip_runtime.h>
#include <hip/hip_cooperative_groups.h>
#include <cstdio>
namespace cg = cooperative_groups;

#define LAS __attribute__((address_space(3)))
typedef unsigned short bf16_t;
typedef short bf16x8 __attribute__((ext_vector_type(8)));
typedef float f32x4 __attribute__((ext_vector_type(4)));
typedef unsigned u32x4 __attribute__((ext_vector_type(4)));
typedef unsigned u32x2 __attribute__((ext_vector_type(2)));

constexpr int D = 2048, NB = 4, T = 4096, CTXL = 256, DFF = 8192;
constexpr int ROWS_LAT = NB * T, ROWS_CTX = NB * CTXL, ROWS = ROWS_LAT + ROWS_CTX;
constexpr int NIN = 4352;
constexpr float ALPHA = 1.4142135623730951f;
constexpr float QSCALE = 0.08838834764831845f;

constexpr size_t SZ_XB = (size_t)ROWS * D * 4, SZ_H = (size_t)ROWS * D * 2;
constexpr size_t NW_IN = (size_t)NIN * D, NW_OUT = (size_t)D * D, NW_1 = (size_t)DFF * D, NW_2 = (size_t)D * DFF, NW_POOL = 4 * 256 * 256;
constexpr size_t SZ_W = (NW_IN + NW_OUT + NW_1 + NW_2 + NW_POOL) * 2;
constexpr size_t SZ_MODP = 32ull * 2 * 5 * 12288 * 4, SZ_MOD = 2ull * 5 * 12288 * 4;
constexpr size_t OFF_XB = 0, OFF_H = OFF_XB + SZ_XB, OFF_W = OFF_H + SZ_H, OFF_MODP = OFF_W + SZ_W, OFF_MOD = OFF_MODP + SZ_MODP, OFF_BAR = OFF_MOD + SZ_MOD  , OFF_C = OFF_BAR + 16384;
constexpr size_t C_PK = 0, C_PV = C_PK + (size_t)ROWS * 512 * 2, C_PQ = C_PV + (size_t)ROWS * 1024 * 2, C_PG = C_PQ + (size_t)ROWS * 512 * 2, C_PU = C_PG + (size_t)ROWS * 1024 * 2,
                 C_LR = C_PU + (size_t)ROWS * 1024 * 2, C_QT = C_LR + (size_t)ROWS * 32 * 4, C_KHT = C_QT + (size_t)2 * ROWS * 512 * 2, C_P = C_KHT + (size_t)2 * ROWS * 512 * 2,
                 C_VT = C_P + (size_t)2176 * 4096 * 2, C_E = C_VT + (size_t)ROWS * 1024 * 2, C_OB = C_E + (size_t)2176 * 128 * 4, C_END = C_OB + (size_t)ROWS * 1024 * 4;
constexpr size_t C_OF = C_PK;
constexpr size_t C_VTL = C_VT, C_VTC = C_VT + (size_t)ROWS_LAT * 1024 * 2;
constexpr size_t C_RESID = C_VT;
constexpr size_t C_A1 = 0;
constexpr size_t C_PART2 = C_QT;
constexpr size_t C_PART4 = (size_t)ROWS * 8192 * 2;
constexpr size_t SZ_PART = (size_t)8 * ROWS_CTX * D * 4;
static_assert(SZ_PART <= C_P - C_QT, "PART2 fits");
constexpr size_t WS_NEED = OFF_C + (C_PART4 + SZ_PART > C_END ? C_PART4 + SZ_PART : C_END);
static_assert((size_t)ROWS * 8192 * 2 <= C_END, "A1 fits");

struct Params {
    const float *x, *c, *ctx, *c_ctx, *w_ada, *b_ada, *w_in, *w_gate_up, *b_gate, *gla_norm_g, *w_pool, *pool_scale, *w_out, *ln1_g, *ln1_b, *w_mlp1, *b_mlp1, *w_mlp2, *b_mlp2, *ln2_g, *ln2_b;
    float* out; unsigned char* ws;
};

typedef __bf16 v2bf_t __attribute__((ext_vector_type(2)));
typedef float v2f_t __attribute__((ext_vector_type(2)));
__device__ __forceinline__ unsigned pk2(float lo, float hi) { const v2f_t f = {lo, hi}; const v2bf_t b = __builtin_convertvector(f, v2bf_t); return __builtin_bit_cast(unsigned, b); }
__device__ __forceinline__ bf16_t bf1(float v) { return (bf16_t)pk2(v, 0.f); }
__device__ __forceinline__ float bflo(unsigned w) { return __uint_as_float(w << 16); }
__device__ __forceinline__ float bfhi(unsigned w) { return __uint_as_float(w & 0xffff0000u); }
__device__ __forceinline__ float wave_sum(float v) {
#pragma unroll
    for (int o = 1; o < 64; o <<= 1) v += __shfl_xor(v, o);
    return v;
}
__device__ __forceinline__ int opaque_tid() { int t = threadIdx.x; asm volatile("" : "+v"(t)); return t; }
__device__ __forceinline__ int opaque_s(int v) { asm volatile("" : "+s"(v)); return v; }
__device__ __forceinline__ float siluf(float v) { return v / (1.f + __expf(-v)); }
__device__ __forceinline__ float log_sigmoidf(float z) { return fminf(z, 0.f) - log1pf(__expf(-fabsf(z))); }

namespace pg8 {
constexpr int BM = 256, BK = 64, HALF = 128, HTB = HALF * BK * 2, STAGE_BYTES = 8 * HTB, NXCD = 8, WGM = 8;
__host__ __device__ __forceinline__ int lds_byte(int r, int c) { const int st = (r >> 4) * 2 + (c >> 5), rr = r & 15, cc = c & 31, ob = rr * 64 + cc * 2; return st * 1024 + (ob ^ (((ob >> 9) & 1) << 5)); }
__host__ __device__ __forceinline__ void stage_rc(int b, int& R, int& C) { const int st = b / 1024, sb = b % 1024, swz = sb ^ (((sb >> 9) & 1) << 5); R = (st >> 1) * 16 + swz / 64; C = (st & 1) * 32 + (swz % 64) / 2; }
__host__ __device__ __forceinline__ int perm32(int rho) { const int n = rho >> 4, i = rho & 15; return 8 * (i >> 2) + 4 * n + (i & 3); }
struct Unit { int pm, pn, kt0, nkt, part; };
struct Gemm { const bf16_t* A; const bf16_t* Bt; int M, N, K, lda, ldb, a_pn_off; };
struct StaticOrder {
    int nM, nN, nwg, G, c, nt, ks, nsub;
    __device__ __forceinline__ void init(int M, int N, int G_, int c_) { nM = M / BM; nN = N / BM; nwg = nM * nN; G = G_; c = c_; nt = 0; ks = 1; nsub = 0; }
    __device__ __forceinline__ void init_split(int Mlat, int N, int G_, int c_, int ctx_tiles, int ks_) { nM = Mlat / BM; nN = N / BM; nwg = nM * nN; G = G_; c = c_; nt = 0; ks = ks_; nsub = ctx_tiles * nN * ks_; }
    __device__ __forceinline__ Unit next(int i) const {
        Unit u; u.pm = 0; u.pn = 0; u.kt0 = 0; u.nkt = 0; u.part = -1;
        const long L = (long)i * G + c;
        if (L >= nwg) { const int sidx = (int)(L - nwg);
            if (sidx < nsub) { const int tile = sidx / ks; u.part = sidx % ks; u.pm = nM + tile / nN; u.pn = tile % nN; u.nkt = nt / ks; u.kt0 = u.part * u.nkt; }
            return u; }
        int wgid = (int)L; { const int q = nwg / NXCD, r = nwg % NXCD, xcd = wgid % NXCD, off = wgid / NXCD; wgid = (xcd < r ? xcd * (q + 1) : r * (q + 1) + (xcd - r) * q) + off; }
        const int nig = WGM * nN, gid = wgid / nig, fm = gid * WGM, gsz = (nM - fm) < WGM ? (nM - fm) : WGM;
        u.pm = fm + ((wgid % nig) % gsz); u.pn = (wgid % nig) / gsz; u.nkt = nt; return u;
    }
};

template <class Epi>
__device__ __forceinline__ void gemm_phase(LAS unsigned char* lds, const Gemm g, StaticOrder S, const Epi& E) {
    const int tid = opaque_tid(), wid = __builtin_amdgcn_readfirstlane(tid >> 6), lane = tid & 63, wr = wid >> 2, wc = wid & 3, fr = lane & 15, fq = lane >> 4;
    int K_ = g.K; asm volatile("" : "+s"(K_));
    const int K = K_; S.nt = K / BK;
    unsigned voffA[2], voffB[2];
#pragma unroll
    for (int i = 0; i < 2; ++i) { int R, C; stage_rc(tid * 16 + i * 8192, R, C); const int Rb = Epi::PERM ? ((R & ~31) + perm32(R & 31)) : R;
        voffA[i] = (unsigned)(R * g.lda + C) * 2u; voffB[i] = (unsigned)(Rb * g.ldb + C) * 2u; }
    const size_t kstep = (size_t)(BK * 2);
    const size_t hstepA = (size_t)HALF * g.lda * 2, hstepB = (size_t)HALF * g.ldb * 2;
    const size_t tstepA = 2 * hstepA, tstepB = 2 * hstepB;
    const unsigned ldsw = (unsigned)wid * 1024u;
    const int aoff = lds_byte(wr * 64 + fr, fq * 8), boff = lds_byte(wc * 32 + fr, fq * 8);
#define PG8_SA(b, h) (((b) * 2 + (h)) * HTB)
#define PG8_SB(b, h) ((4 + (b) * 2 + (h)) * HTB)
#define PG8_STAGE(bufoff, gbase, voff) do { _Pragma("unroll") for (int _i = 0; _i < 2; ++_i) \
        __builtin_amdgcn_global_load_lds((const unsigned*)((const char*)(gbase) + (voff)[_i]), (LAS unsigned*)(lds + (bufoff) + ldsw + _i * 8192), 16, 0, 0); } while (0)
#define PG8_LDA(dst, b, h) do { _Pragma("unroll") for (int m = 0; m < 4; ++m) _Pragma("unroll") for (int k = 0; k < 2; ++k) dst[m][k] = *(const LAS bf16x8*)(lds + PG8_SA(b, h) + aoff + m * 2048 + k * 1024); } while (0)
#define PG8_LDB(dst, b, h) do { _Pragma("unroll") for (int n = 0; n < 2; ++n) _Pragma("unroll") for (int k = 0; k < 2; ++k) dst[n][k] = *(const LAS bf16x8*)(lds + PG8_SB(b, h) + boff + n * 2048 + k * 1024); } while (0)
#define PG8_MMA(ai, bj, At, Bt) do { __builtin_amdgcn_s_setprio(1); _Pragma("unroll") for (int m = 0; m < 4; ++m) _Pragma("unroll") for (int n = 0; n < 2; ++n) _Pragma("unroll") for (int k = 0; k < 2; ++k) \
        acc[ai][bj][m][n] = __builtin_amdgcn_mfma_f32_16x16x32_bf16(Bt[n][k], At[m][k], acc[ai][bj][m][n], 0, 0, 0); __builtin_amdgcn_s_setprio(0); } while (0)
#define PG8_WAIT_V(n) asm volatile("s_waitcnt vmcnt(" #n ")" ::: "memory")
#define PG8_WAIT_L(n) asm volatile("s_waitcnt lgkmcnt(" #n ")" ::: "memory")
#define PG8_BAR __builtin_amdgcn_s_barrier()
#define PG8_SCHED __builtin_amdgcn_sched_barrier(0)
    Unit cur = S.next(0), nxt; int ui = 0;
    if (cur.nkt == 0) return;
    f32x4 acc[2][2][4][2];
#pragma unroll
    for (int a = 0; a < 2; ++a)
#pragma unroll
        for (int b = 0; b < 2; ++b)
#pragma unroll
            for (int m = 0; m < 4; ++m)
#pragma unroll
                for (int n = 0; n < 2; ++n) acc[a][b][m][n] = (f32x4){0.f, 0.f, 0.f, 0.f};
    bf16x8 At[4][2], B0[2][2], B1[2][2];
    const char* cA = (const char*)g.A + (size_t)cur.pm * tstepA + (size_t)cur.pn * g.a_pn_off + (size_t)cur.kt0 * kstep; const char* cB = (const char*)g.Bt + (size_t)cur.pn * tstepB + (size_t)cur.kt0 * kstep;
    PG8_STAGE(PG8_SB(0, 0), cB, voffB); PG8_STAGE(PG8_SA(0, 0), cA, voffA); PG8_STAGE(PG8_SB(0, 1), cB + hstepB, voffB); PG8_STAGE(PG8_SA(0, 1), cA + hstepA, voffA);
    if (wr == 1) PG8_BAR;
    PG8_WAIT_V(4); PG8_BAR;
    PG8_STAGE(PG8_SB(1, 0), cB + kstep, voffB); PG8_STAGE(PG8_SA(1, 0), cA + kstep, voffA); PG8_STAGE(PG8_SB(1, 1), cB + hstepB + kstep, voffB);
    PG8_WAIT_V(6); PG8_BAR;
    for (;;) {
        nxt = S.next(ui + 1); const bool has_next = nxt.nkt != 0;
        const char* nA = has_next ? (const char*)g.A + (size_t)nxt.pm * tstepA + (size_t)nxt.pn * g.a_pn_off + (size_t)nxt.kt0 * kstep : cA; const char* nB = has_next ? (const char*)g.Bt + (size_t)nxt.pn * tstepB + (size_t)nxt.kt0 * kstep : cB;
        const int ntc = cur.nkt;
        for (int t = 0; t < ntc; t += 2) {
            const bool last = (t == ntc - 2);
            const char* a1 = cA + (size_t)(t + 1) * kstep;
            const char* a2 = last ? nA : cA + (size_t)(t + 2) * kstep; const char* b2 = last ? nB : cB + (size_t)(t + 2) * kstep;
            const char* a3 = a2 + kstep; const char* b3 = b2 + kstep;
            PG8_LDB(B0, 0, 0); PG8_SCHED; PG8_LDA(At, 0, 0); PG8_STAGE(PG8_SA(1, 1), a1 + hstepA, voffA);
            PG8_WAIT_L(8); PG8_BAR; PG8_WAIT_L(0); PG8_MMA(0, 0, At, B0); PG8_BAR; PG8_SCHED;
            PG8_LDB(B1, 0, 1); PG8_STAGE(PG8_SB(0, 0), b2, voffB);
            PG8_BAR; PG8_WAIT_L(0); PG8_MMA(0, 1, At, B1); PG8_BAR;
            PG8_LDA(At, 0, 1); PG8_STAGE(PG8_SA(0, 0), a2, voffA);
            PG8_BAR; PG8_WAIT_L(0); PG8_MMA(1, 0, At, B0); PG8_BAR; PG8_SCHED;
            PG8_STAGE(PG8_SB(0, 1), b2 + hstepB, voffB);
            PG8_WAIT_V(6); PG8_BAR; PG8_MMA(1, 1, At, B1); PG8_BAR;
            PG8_LDB(B0, 1, 0); PG8_SCHED; PG8_LDA(At, 1, 0); PG8_STAGE(PG8_SA(0, 1), a2 + hstepA, voffA);
            PG8_WAIT_L(8); PG8_BAR; PG8_WAIT_L(0); PG8_MMA(0, 0, At, B0); PG8_BAR; PG8_SCHED;
            PG8_LDB(B1, 1, 1); PG8_STAGE(PG8_SB(1, 0), b3, voffB);
            PG8_BAR; PG8_WAIT_L(0); PG8_MMA(0, 1, At, B1); PG8_BAR;
            PG8_LDA(At, 1, 1); PG8_STAGE(PG8_SA(1, 0), a3, voffA);
            PG8_BAR; PG8_WAIT_L(0); PG8_MMA(1, 0, At, B0); PG8_BAR; PG8_SCHED;
            PG8_STAGE(PG8_SB(1, 1), b3 + hstepB, voffB);
            PG8_WAIT_V(6); PG8_BAR; PG8_MMA(1, 1, At, B1); PG8_BAR;
        }
        E(acc, cur, wr, wc, fr, fq);
        if (!has_next) break;
#pragma unroll
        for (int a = 0; a < 2; ++a)
#pragma unroll
            for (int b = 0; b < 2; ++b)
#pragma unroll
                for (int m = 0; m < 4; ++m)
#pragma unroll
                    for (int n = 0; n < 2; ++n) acc[a][b][m][n] = (f32x4){0.f, 0.f, 0.f, 0.f};
        cur = nxt; cA = nA; cB = nB; ++ui;
    }
    PG8_WAIT_V(0);
    if (wr == 0) PG8_BAR;
    PG8_BAR;
#undef PG8_SA
#undef PG8_SB
#undef PG8_STAGE
#undef PG8_LDA
#undef PG8_LDB
#undef PG8_MMA
#undef PG8_WAIT_V
#undef PG8_WAIT_L
#undef PG8_BAR
#undef PG8_SCHED
}
}
using pg8::Unit;

struct EpiIn {
    static constexpr bool PERM = true;
    bf16_t *pk, *vtl, *vtc, *pq, *pg, *pu; float* lr;
    __device__ __forceinline__ void operator()(const f32x4 (&acc)[2][2][4][2], const Unit& u, int wr, int wc, int fr, int fq) const {
        const int row0 = u.pm * 256 + wr * 64 + fr;
        if (u.pn >= 2 && u.pn < 6) {
            const int cb = (u.pn - 2) * 256 + wc * 32 + 8 * fq;
            bf16_t* vb; int tl, t0;
            if (u.pm < 64) { vb = vtl + (size_t)(u.pm >> 4) * 1024 * T; tl = T; t0 = (u.pm & 15) * 256; } else { vb = vtc + (size_t)(u.pm - 64) * 1024 * CTXL; tl = CTXL; t0 = 0; }
            t0 += wr * 64 + fr;
#pragma unroll
            for (int ai = 0; ai < 2; ++ai)
#pragma unroll
                for (int m = 0; m < 4; ++m) { bf16_t* tp = vb + t0 + ai * 128 + m * 16;
#pragma unroll
                    for (int bj = 0; bj < 2; ++bj)
#pragma unroll
                        for (int n = 0; n < 2; ++n) { const f32x4 v = acc[ai][bj][m][n]; const unsigned w0 = pk2(v[0], v[1]), w1 = pk2(v[2], v[3]); const size_t c = (size_t)(cb + bj * 128 + 4 * n) * tl;
                            tp[c] = (bf16_t)w0; tp[c + tl] = (bf16_t)(w0 >> 16); tp[c + 2 * (size_t)tl] = (bf16_t)w1; tp[c + 3 * (size_t)tl] = (bf16_t)(w1 >> 16); } }
        } else if (u.pn < 16) {
            bf16_t* base; int ld, colt;
            if (u.pn < 2) { base = pk; ld = 512; colt = u.pn * 256; }
            else if (u.pn < 8) { base = pq; ld = 512; colt = (u.pn - 6) * 256; }
            else if (u.pn < 12) { base = pg; ld = 1024; colt = (u.pn - 8) * 256; }
            else { base = pu; ld = 1024; colt = (u.pn - 12) * 256; }
            const int col0 = colt + wc * 32 + 8 * fq;
#pragma unroll
            for (int ai = 0; ai < 2; ++ai)
#pragma unroll
                for (int m = 0; m < 4; ++m) { bf16_t* rowp = base + (size_t)(row0 + ai * 128 + m * 16) * ld + col0;
#pragma unroll
                    for (int bj = 0; bj < 2; ++bj) { const f32x4 v0 = acc[ai][bj][m][0], v1 = acc[ai][bj][m][1];
                        u32x4 w; w.x = pk2(v0[0], v0[1]); w.y = pk2(v0[2], v0[3]); w.z = pk2(v1[0], v1[1]); w.w = pk2(v1[2], v1[3]);
                        *(u32x4*)(rowp + bj * 128) = w; } }
        } else if (wc == 0) {
#pragma unroll
            for (int ai = 0; ai < 2; ++ai)
#pragma unroll
                for (int m = 0; m < 4; ++m) { float* rowp = lr + (size_t)(row0 + ai * 128 + m * 16) * 32 + 8 * fq;
                    *(f32x4*)(rowp) = acc[ai][0][m][0]; *(f32x4*)(rowp + 4) = acc[ai][0][m][1]; }
        }
    }
};
struct EpiPool {
    static constexpr bool PERM = true;
    bf16_t* mixed; const float* scale;
    __device__ __forceinline__ void operator()(const f32x4 (&acc)[2][2][4][2], const Unit& u, int wr, int wc, int fr, int fq) const {
        const int row0 = u.pm * 256 + wr * 64 + fr, col0 = u.pn * 256 + wc * 32 + 8 * fq;
        f32x4 sv[2][2];
#pragma unroll
        for (int bj = 0; bj < 2; ++bj)
#pragma unroll
            for (int n = 0; n < 2; ++n) sv[bj][n] = scale ? *(const f32x4*)(scale + col0 + bj * 128 + 4 * n) : (f32x4){1.f, 1.f, 1.f, 1.f};
#pragma unroll
        for (int ai = 0; ai < 2; ++ai)
#pragma unroll
            for (int m = 0; m < 4; ++m) { bf16_t* rowp = mixed + (size_t)(row0 + ai * 128 + m * 16) * D + 1024 + col0;
#pragma unroll
                for (int bj = 0; bj < 2; ++bj) { const f32x4 v0 = acc[ai][bj][m][0] * sv[bj][0], v1 = acc[ai][bj][m][1] * sv[bj][1];
                    u32x4 w; w.x = pk2(v0[0], v0[1]); w.y = pk2(v0[2], v0[3]); w.z = pk2(v1[0], v1[1]); w.w = pk2(v1[2], v1[3]);
                    *(u32x4*)(rowp + bj * 128) = w; } }
    }
};
struct EpiMlp1 {
    static constexpr bool PERM = true;
    bf16_t* a1; const float* bias;
    __device__ __forceinline__ void operator()(const f32x4 (&acc)[2][2][4][2], const Unit& u, int wr, int wc, int fr, int fq) const {
        const int row0 = u.pm * 256 + wr * 64 + fr, col0 = u.pn * 256 + wc * 32 + 8 * fq;
        f32x4 bv[2][2];
#pragma unroll
        for (int bj = 0; bj < 2; ++bj)
#pragma unroll
            for (int n = 0; n < 2; ++n) bv[bj][n] = *(const f32x4*)(bias + col0 + bj * 128 + 4 * n);
#pragma unroll
        for (int ai = 0; ai < 2; ++ai)
#pragma unroll
            for (int m = 0; m < 4; ++m) { bf16_t* rowp = a1 + (size_t)(row0 + ai * 128 + m * 16) * DFF + col0;
#pragma unroll
                for (int bj = 0; bj < 2; ++bj) { f32x4 v0 = acc[ai][bj][m][0] + bv[bj][0], v1 = acc[ai][bj][m][1] + bv[bj][1];
#pragma unroll
                    for (int j = 0; j < 4; ++j) { const float a = fmaxf(v0[j], 0.f), b = fmaxf(v1[j], 0.f); v0[j] = a * a; v1[j] = b * b; }
                    u32x4 w; w.x = pk2(v0[0], v0[1]); w.y = pk2(v0[2], v0[3]); w.z = pk2(v1[0], v1[1]); w.w = pk2(v1[2], v1[3]);
                    *(u32x4*)(rowp + bj * 128) = w; } }
    }
};
struct EpiDelta {
    static constexpr bool PERM = true;
    bf16_t* delta; const float* gate  ; const float* bias; float* part  ;
    __device__ __forceinline__ void operator()(const f32x4 (&acc)[2][2][4][2], const Unit& u, int wr, int wc, int fr, int fq) const {
        const int row0 = u.pm * 256 + wr * 64 + fr, col0 = u.pn * 256 + wc * 32 + 8 * fq;
        if (u.part >= 0) {
            float* pp = part + ((size_t)u.part * ROWS_CTX + (row0 - ROWS_LAT)) * D + col0;
#pragma unroll
            for (int ai = 0; ai < 2; ++ai)
#pragma unroll
                for (int m = 0; m < 4; ++m)
#pragma unroll
                    for (int bj = 0; bj < 2; ++bj)
#pragma unroll
                        for (int n = 0; n < 2; ++n) *(f32x4*)(pp + (size_t)(ai * 128 + m * 16) * D + bj * 128 + 4 * n) = acc[ai][bj][m][n];
            return;
        }
        const int mr = u.pm < 64 ? (u.pm >> 4) : 4;
        const float* gp = gate + (size_t)mr * 6 * D + col0;
        f32x4 gv[2][2], bv[2][2];
#pragma unroll
        for (int bj = 0; bj < 2; ++bj)
#pragma unroll
            for (int n = 0; n < 2; ++n) { gv[bj][n] = *(const f32x4*)(gp + bj * 128 + 4 * n); bv[bj][n] = bias ? *(const f32x4*)(bias + col0 + bj * 128 + 4 * n) : (f32x4){0.f, 0.f, 0.f, 0.f}; }
#pragma unroll
        for (int ai = 0; ai < 2; ++ai)
#pragma unroll
            for (int m = 0; m < 4; ++m) { bf16_t* rowp = delta + (size_t)(row0 + ai * 128 + m * 16) * D + col0;
#pragma unroll
                for (int bj = 0; bj < 2; ++bj) { const f32x4 v0 = gv[bj][0] * (acc[ai][bj][m][0] + bv[bj][0]), v1 = gv[bj][1] * (acc[ai][bj][m][1] + bv[bj][1]);
                    u32x4 w; w.x = pk2(v0[0], v0[1]); w.y = pk2(v0[2], v0[3]); w.z = pk2(v1[0], v1[1]); w.w = pk2(v1[2], v1[3]);
                    *(u32x4*)(rowp + bj * 128) = w; } }
    }
};

__device__ __forceinline__ void modp_task(const Params& p, int l, int task, LAS float* sl) {
    const int tid = opaque_tid();
    const int s = task / 6, nb = task % 6;
    const int k0 = s * 64, n0 = nb * 2048 + tid * 4;
    if (tid < 320) { const int r = tid >> 6, kk = tid & 63; const float cv = r < 4 ? p.c[r * D + k0 + kk] : p.c_ctx[k0 + kk]; sl[tid] = siluf(cv); }
    __syncthreads();
    f32x4 acc[5];
#pragma unroll
    for (int r = 0; r < 5; ++r) acc[r] = (f32x4){0.f, 0.f, 0.f, 0.f};
    const float* wp = p.w_ada + ((size_t)l * D + k0) * 12288 + n0;
#pragma unroll 8
    for (int kk = 0; kk < 64; ++kk) { const f32x4 w = __builtin_nontemporal_load((const f32x4*)(wp + (size_t)kk * 12288));
#pragma unroll
        for (int r = 0; r < 5; ++r) acc[r] += sl[r * 64 + kk] * w; }
    float* mp = (float*)(p.ws + OFF_MODP) + ((size_t)(s * 2 + l) * 5) * 12288 + n0;
#pragma unroll
    for (int r = 0; r < 5; ++r) *(f32x4*)(mp + (size_t)r * 12288) = acc[r];
    __syncthreads();
}
constexpr int CVT_ITEMS = 4352 + 2048 + 8192 + 8192 + 128;
constexpr int CVT_SPLIT = 4352 + 5500;
__device__ __forceinline__ void convert_item(const Params& p, int l, int it, LAS float* scr, int lane) {
    const float* src; bf16_t* dst; int K, ld, nbn, mode = 0, pgi = 0;
    bf16_t* wb = (bf16_t*)(p.ws + OFF_W);
    if (it < 4352) { src = p.w_in + (size_t)l * D * 4128; ld = 4128; K = 2048; nbn = 136; dst = wb; mode = 1; }
    else if ((it -= 4352) < 2048) { src = p.w_out + (size_t)l * D * D; ld = 2048; K = 2048; nbn = 64; dst = wb + NW_IN; }
    else if ((it -= 2048) < 8192) { src = p.w_mlp1 + (size_t)l * D * DFF; ld = 8192; K = 2048; nbn = 256; dst = wb + NW_IN + NW_OUT; }
    else if ((it -= 8192) < 8192) { src = p.w_mlp2 + (size_t)l * DFF * D; ld = 2048; K = 8192; nbn = 64; dst = wb + NW_IN + NW_OUT + NW_1; }
    else { it -= 8192; const int gi = it >> 5; it &= 31; src = p.w_pool + ((size_t)l * 4 + gi) * 65536; ld = 256; K = 256; nbn = 8; dst = wb + NW_IN + NW_OUT + NW_1 + NW_2 + (size_t)gi * 65536; mode = 2; pgi = gi; }
    const int kb = it / nbn, nb = it % nbn, k0 = 64 * kb, n0 = 32 * nb;
    if (mode == 2) {
        const float sc_ = p.pool_scale[l * 1024 + pgi * 256 + n0 + (lane & 31)];
#pragma unroll 8
        for (int i = 0; i < 32; ++i) { const int kk = 2 * i + (lane >> 5); dst[(size_t)(k0 + kk) * 256 + n0 + (lane & 31)] = bf1(src[(size_t)(k0 + kk) * 256 + n0 + (lane & 31)] * sc_); }
        return;
    }
    int ns = n0;
    if (mode == 1) ns = n0 < 1536 ? n0 : (n0 < 4096 ? n0 + 32 : (n0 < 4128 ? 1536 + (n0 - 4096) : -1));
    if (ns >= 0) {
        const int kr = lane >> 3, nq = lane & 7; f32x4 t[8];
#pragma unroll
        for (int i = 0; i < 8; ++i) t[i] = __builtin_nontemporal_load((const f32x4*)(src + (size_t)(k0 + 8 * i + kr) * ld + ns + 4 * nq));
#pragma unroll
        for (int i = 0; i < 8; ++i) { LAS float* q = scr + (8 * i + kr) * 33 + 4 * nq; q[0] = t[i][0]; q[1] = t[i][1]; q[2] = t[i][2]; q[3] = t[i][3]; }
    } else {
#pragma unroll 8
        for (int i = 0; i < 32; ++i) { const int kk = 2 * i + (lane >> 5); scr[kk * 33 + (lane & 31)] = 0.f; }
    }
    asm volatile("s_waitcnt lgkmcnt(0)" ::: "memory");
    const int c = lane & 7;
#pragma unroll
    for (int j = 0; j < 4; ++j) { const int n = (lane >> 3) + 8 * j; const LAS float* s = scr + (8 * c) * 33 + n;
        u32x4 o; o.x = pk2(s[0 * 33], s[1 * 33]); o.y = pk2(s[2 * 33], s[3 * 33]); o.z = pk2(s[4 * 33], s[5 * 33]); o.w = pk2(s[6 * 33], s[7 * 33]);
        *(u32x4*)(dst + (size_t)(n0 + n) * K + k0 + 8 * c) = o; }
    asm volatile("s_waitcnt lgkmcnt(0)" ::: "memory");
}
__device__ __forceinline__ void convert_phase(const Params& p, int l, LAS float* ldsf, int it_lo, int it_hi, int wg0, int nwg) {
    const int tid = opaque_tid(), lane = tid & 63, wave = tid >> 6;
    LAS float* scr = ldsf + wave * (64 * 33);
    for (int it = it_lo + ((int)blockIdx.x - wg0) * 8 + wave; it < it_hi; it += nwg * 8) convert_item(p, l, it, scr, lane);
}
__device__ __forceinline__ void ln_phase(int nrows, const float* src_lat, const float* src_ctx, const float* g, const float* b, float* dst_lat, float* dst_ctx,
                                         const float* modl  , int jsh, int jsc, bf16_t* hout,
                                         const bf16_t* delta = nullptr, const float* part = nullptr, const float* pgate = nullptr, const float* pbias = nullptr) {
    const int tid_ = opaque_tid(), lane = tid_ & 63, wave = tid_ >> 6;
    const int stride = gridDim.x * 8;
    int r = blockIdx.x * 8 + wave;
    f32x4 nv[8]; u32x4 nd[4];
#define LN_C(i) ((lane + 64 * ((i) >> 1)) * 8 + ((i) & 1) * 4)
#define LN_LOAD(rr) do { const float* src_ = (rr) < ROWS_LAT ? src_lat + (size_t)(rr) * D : src_ctx + (size_t)((rr) - ROWS_LAT) * D; \
        _Pragma("unroll") for (int i = 0; i < 8; ++i) nv[i] = *(const f32x4*)(src_ + LN_C(i)); \
        if (delta) { const bf16_t* dp_ = delta + (size_t)(rr) * D; _Pragma("unroll") for (int i = 0; i < 4; ++i) nd[i] = *(const u32x4*)(dp_ + (lane + 64 * i) * 8); } } while (0)
#pragma unroll
    for (int i = 0; i < 4; ++i) nd[i] = (u32x4){0u, 0u, 0u, 0u};
    if (r < nrows) LN_LOAD(r);
    for (; r < nrows; r += stride) {
        f32x4 v[8]; u32x4 dl[4];
#pragma unroll
        for (int i = 0; i < 8; ++i) v[i] = nv[i];
#pragma unroll
        for (int i = 0; i < 4; ++i) dl[i] = nd[i];
        const int rn = r + stride;
        if (rn < nrows) LN_LOAD(rn);
        if (delta && !(part && r >= ROWS_LAT)) {
#pragma unroll
            for (int i = 0; i < 4; ++i) { v[2 * i] = ALPHA * v[2 * i] + (f32x4){bflo(dl[i].x), bfhi(dl[i].x), bflo(dl[i].y), bfhi(dl[i].y)}; v[2 * i + 1] = ALPHA * v[2 * i + 1] + (f32x4){bflo(dl[i].z), bfhi(dl[i].z), bflo(dl[i].w), bfhi(dl[i].w)}; }
        }
        if (part && r >= ROWS_LAT) {
            f32x4 a[8];
#pragma unroll
            for (int i = 0; i < 8; ++i) a[i] = pbias ? *(const f32x4*)(pbias + LN_C(i)) : (f32x4){0.f, 0.f, 0.f, 0.f};
#pragma unroll 1
            for (int k = 0; k < 8; ++k) { const float* pp = part + ((size_t)k * ROWS_CTX + (r - ROWS_LAT)) * D;
#pragma unroll
                for (int i = 0; i < 8; ++i) a[i] += *(const f32x4*)(pp + LN_C(i)); }
#pragma unroll
            for (int i = 0; i < 8; ++i) v[i] = ALPHA * v[i] + *(const f32x4*)(pgate + LN_C(i)) * a[i];
        }
        if (g) {
            float s = 0.f;
#pragma unroll
            for (int i = 0; i < 8; ++i) s += (v[i][0] + v[i][1]) + (v[i][2] + v[i][3]);
            const float mean = wave_sum(s) * (1.f / D); float q = 0.f;
#pragma unroll
            for (int i = 0; i < 8; ++i) { v[i] = v[i] - mean; q += (v[i][0] * v[i][0] + v[i][1] * v[i][1]) + (v[i][2] * v[i][2] + v[i][3] * v[i][3]); }
            const float rstd = 1.f / sqrtf(wave_sum(q) * (1.f / D) + 1e-6f);
            float* dst = r < ROWS_LAT ? (dst_lat ? dst_lat + (size_t)r * D : nullptr) : (dst_ctx ? dst_ctx + (size_t)(r - ROWS_LAT) * D : nullptr);
#pragma unroll
            for (int i = 0; i < 8; ++i) { const int c = LN_C(i); v[i] = v[i] * rstd * *(const f32x4*)(g + c) + *(const f32x4*)(b + c); if (dst) *(f32x4*)(dst + c) = v[i]; }
        }
        if (hout) {
            const int mr = r < ROWS_LAT ? (r >> 12) : 4;
            const float* sh = modl + ((size_t)mr * 6 + jsh) * D; const float* sc = modl + ((size_t)mr * 6 + jsc) * D;
            float s = 0.f;
#pragma unroll
            for (int i = 0; i < 8; ++i) s += (v[i][0] + v[i][1]) + (v[i][2] + v[i][3]);
            const float mean = wave_sum(s) * (1.f / D); float q = 0.f;
#pragma unroll
            for (int i = 0; i < 8; ++i) { v[i] = v[i] - mean; q += (v[i][0] * v[i][0] + v[i][1] * v[i][1]) + (v[i][2] * v[i][2] + v[i][3] * v[i][3]); }
            const float rstd = 1.f / sqrtf(wave_sum(q) * (1.f / D) + 1e-6f);
            bf16_t* hp = hout + (size_t)r * D;
#pragma unroll
            for (int i = 0; i < 4; ++i) { const int c = (lane + 64 * i) * 8;
                const f32x4 o0 = v[2 * i] * rstd * (1.f + *(const f32x4*)(sc + c)) + *(const f32x4*)(sh + c), o1 = v[2 * i + 1] * rstd * (1.f + *(const f32x4*)(sc + c + 4)) + *(const f32x4*)(sh + c + 4);
                u32x4 w; w.x = pk2(o0[0], o0[1]); w.y = pk2(o0[2], o0[3]); w.z = pk2(o1[0], o1[1]); w.w = pk2(o1[2], o1[3]); *(u32x4*)(hp + c) = w; }
        }
    }
#undef LN_LOAD
#undef LN_C
}
__device__ __forceinline__ void gla_prep(const Params& p, int l, LAS unsigned char* lds) {
    const int tid = opaque_tid(), lane = tid & 63, wave = __builtin_amdgcn_readfirstlane(tid >> 6), fr = lane & 15, fq = lane >> 4;
    LAS bf16_t* qts = (LAS bf16_t*)lds;
    LAS bf16_t* kts = (LAS bf16_t*)(lds + 17408);
    LAS bf16_t* khs = (LAS bf16_t*)(lds + 34816);
    LAS bf16_t* ps = (LAS bf16_t*)(lds + 53248);
    LAS float* lrs = (LAS float*)(lds + 62464);
    LAS float* gts = (LAS float*)(lds + 66560);
    unsigned char* C = p.ws + OFF_C;
    const bf16_t* pq = (const bf16_t*)(C + C_PQ); const bf16_t* pk = (const bf16_t*)(C + C_PK); const float* lr = (const float*)(C + C_LR);
    const int d = tid & 127, mg = tid >> 7;
    f32x4 nlr = {0.f, 0.f, 0.f, 0.f}; float nwu[16], nbg = 0.f; unsigned short nq[16], nk[16];
#define PREP_LOAD(item_) do { const int chain_ = (item_) / 68, mc_ = (item_) % 68, b_ = chain_ >> 3, h_ = (chain_ >> 1) & 3, dir_ = chain_ & 1; \
        const int rb_ = mc_ < 4 ? ROWS_LAT + b_ * CTXL + mc_ * 64 : b_ * T + (mc_ - 4) * 64; \
        if (tid < 256) nlr = *(const f32x4*)(lr + (size_t)(rb_ + (tid >> 2)) * 32 + dir_ * 16 + (tid & 3) * 4); \
        _Pragma("unroll") for (int r = 0; r < 16; ++r) nwu[r] = p.w_gate_up[((size_t)(l * 2 + dir_) * 16 + r) * 512 + h_ * 128 + d]; \
        nbg = p.b_gate[(size_t)(l * 2 + dir_) * 512 + h_ * 128 + d]; \
        _Pragma("unroll") for (int j = 0; j < 16; ++j) { nq[j] = pq[(size_t)(rb_ + mg * 16 + j) * 512 + h_ * 128 + d]; nk[j] = pk[(size_t)(rb_ + mg * 16 + j) * 512 + h_ * 128 + d]; } } while (0)
    if ((int)blockIdx.x < 2176) PREP_LOAD((int)blockIdx.x);
    for (int item = blockIdx.x; item < 2176; item += gridDim.x) {
        const int chain = item / 68, mc = item % 68, dir = chain & 1;
        if (tid < 256) *(LAS f32x4*)(lrs + (tid >> 2) * 16 + (tid & 3) * 4) = nlr;
        float wu[16]; unsigned short cq[16], ck[16];
#pragma unroll
        for (int r = 0; r < 16; ++r) { wu[r] = nwu[r]; cq[r] = nq[r]; ck[r] = nk[r]; }
        const float bg = nbg;
        __syncthreads();
        if (item + (int)gridDim.x < 2176) PREP_LOAD(item + (int)gridDim.x);
        float la[16];
#pragma unroll
        for (int j = 0; j < 16; ++j) { const int m = mg * 16 + j; float z = bg;
#pragma unroll
            for (int r4 = 0; r4 < 4; ++r4) { const f32x4 x = *(const LAS f32x4*)(lrs + m * 16 + r4 * 4); z += x[0] * wu[r4 * 4] + x[1] * wu[r4 * 4 + 1] + x[2] * wu[r4 * 4 + 2] + x[3] * wu[r4 * 4 + 3]; }
            la[j] = (fminf(z, 0.f) - __logf(1.f + __expf(-fabsf(z)))) * (1.f / 16.f); }
        if (dir == 0) {
#pragma unroll
            for (int j = 1; j < 16; ++j) la[j] += la[j - 1];
        } else {
#pragma unroll
            for (int j = 14; j >= 0; --j) la[j] += la[j + 1];
        }
        gts[mg * 128 + d] = dir == 0 ? la[15] : la[0];
        __syncthreads();
        const float g0 = gts[d], g1 = gts[128 + d], g2 = gts[256 + d], g3 = gts[384 + d];
        const float total = (g0 + g1) + (g2 + g3);
        float off = 0.f;
        if (dir == 0) { if (mg > 0) off += g0; if (mg > 1) off += g1; if (mg > 2) off += g2; } else { if (mg < 3) off += g3; if (mg < 2) off += g2; if (mg < 1) off += g1; }
        float kh[16];
#pragma unroll
        for (int j = 0; j < 16; ++j) { const int m = mg * 16 + j; const float cum = fmaxf(la[j] + off, -80.f);
            const float qv = __uint_as_float(((unsigned)cq[j]) << 16), kv = __uint_as_float(((unsigned)ck[j]) << 16);
            qts[m * 136 + d] = bf1(qv * QSCALE * __expf(cum)); kts[m * 136 + d] = bf1(kv * __expf(-cum)); kh[j] = kv * __expf(total - cum); }
        { u32x4 w0, w1;
          w0.x = pk2(kh[0], kh[1]); w0.y = pk2(kh[2], kh[3]); w0.z = pk2(kh[4], kh[5]); w0.w = pk2(kh[6], kh[7]);
          w1.x = pk2(kh[8], kh[9]); w1.y = pk2(kh[10], kh[11]); w1.z = pk2(kh[12], kh[13]); w1.w = pk2(kh[14], kh[15]);
          *(LAS u32x4*)(khs + d * 72 + mg * 16) = w0; *(LAS u32x4*)(khs + d * 72 + mg * 16 + 8) = w1; }
        if (mg == 0) ((float*)(C + C_E))[(size_t)item * 128 + d] = __expf(total);
        __syncthreads();
#pragma unroll
        for (int tt = 0; tt < 2; ++tt) { const int tile = wave * 2 + tt, it = tile >> 2, jt = tile & 3; f32x4 acc = {0.f, 0.f, 0.f, 0.f};
#pragma unroll
            for (int ks = 0; ks < 4; ++ks) { const bf16x8 a = *(const LAS bf16x8*)(qts + (it * 16 + fr) * 136 + ks * 32 + fq * 8), bb = *(const LAS bf16x8*)(kts + (jt * 16 + fr) * 136 + ks * 32 + fq * 8);
                acc = __builtin_amdgcn_mfma_f32_16x16x32_bf16(a, bb, acc, 0, 0, 0); }
#pragma unroll
            for (int jj = 0; jj < 4; ++jj) { const int i = it * 16 + fq * 4 + jj, jc = jt * 16 + fr; const bool keep = dir == 0 ? (jc <= i) : (jc >= i); ps[i * 72 + jc] = bf1(keep ? acc[jj] : 0.f); } }
        __syncthreads();
        bf16_t* qo = (bf16_t*)(C + C_QT) + (size_t)item * 8192; bf16_t* ko = (bf16_t*)(C + C_KHT) + (size_t)item * 8192; bf16_t* po = (bf16_t*)(C + C_P) + (size_t)item * 4096;
#pragma unroll
        for (int k = 0; k < 2; ++k) { const int q = tid + 512 * k; *(u32x4*)(qo + (q >> 4) * 128 + (q & 15) * 8) = *(const LAS u32x4*)(qts + (q >> 4) * 136 + (q & 15) * 8);
            *(u32x4*)(ko + (q >> 3) * 64 + (q & 7) * 8) = *(const LAS u32x4*)(khs + (q >> 3) * 72 + (q & 7) * 8); }
        *(u32x4*)(po + (tid >> 3) * 64 + (tid & 7) * 8) = *(const LAS u32x4*)(ps + (tid >> 3) * 72 + (tid & 7) * 8);
        __syncthreads();
    }
#undef PREP_LOAD
}
constexpr int CH_BUF = 54784, CH_KH = 17408, CH_P = 35840, CH_V = 45056, CH_E = 54272, CH_ST = 2 * CH_BUF;
__device__ __forceinline__ void gla_chain(const Params& p, LAS unsigned char* lds) {
    if (blockIdx.x >= 128) return;
    const int tid = opaque_tid(), lane = tid & 63, wave = __builtin_amdgcn_readfirstlane(tid >> 6), fr = lane & 15, fq = lane >> 4;
    const int chain = blockIdx.x & 31, vg = blockIdx.x >> 5, b = chain >> 3, h = (chain >> 1) & 3, dir = chain & 1;
    unsigned char* C = p.ws + OFF_C;
    const bf16_t* QTg = (const bf16_t*)(C + C_QT) + (size_t)chain * 68 * 8192; const bf16_t* KHg = (const bf16_t*)(C + C_KHT) + (size_t)chain * 68 * 8192;
    const bf16_t* Pg = (const bf16_t*)(C + C_P) + (size_t)chain * 68 * 4096; const float* Eg = (const float*)(C + C_E) + (size_t)chain * 68 * 128;
    const bf16_t* vtl = (const bf16_t*)(C + C_VTL) + ((size_t)b * 1024 + h * 256 + vg * 64 + (tid >> 3)) * T + (tid & 7) * 8;
    const bf16_t* vtc = (const bf16_t*)(C + C_VTC) + ((size_t)b * 1024 + h * 256 + vg * 64 + (tid >> 3)) * CTXL + (tid & 7) * 8;
    bf16_t* Og = (bf16_t*)(C + (dir ? C_OB : C_OF)) + h * 256 + vg * 64 + (wave & 3) * 16 + fq * 4;
    LAS unsigned char* st = lds + CH_ST + (wave & 3) * 4352;
    u32x4 ra0, ra1, ra2, ra3, ra4, ra5, rb0, rb1, rb2, rb3, rb4, rb5; f32x4 rae = {0.f, 0.f, 0.f, 0.f}, rbe = {0.f, 0.f, 0.f, 0.f};
#define CH_ISSUE_(ci, r0, r1, r2, r3, r4, r5, re) do { const int ci_ = (ci) < 68 ? (ci) : 67; const int mc_ = dir == 0 ? ci_ : (ci_ < 4 ? 3 - ci_ : 71 - ci_); \
        r0 = *(const u32x4*)(QTg + (size_t)mc_ * 8192 + (tid >> 4) * 128 + (tid & 15) * 8); r1 = *(const u32x4*)(QTg + (size_t)mc_ * 8192 + ((tid >> 4) + 32) * 128 + (tid & 15) * 8); \
        r2 = *(const u32x4*)(KHg + (size_t)mc_ * 8192 + (tid >> 3) * 64 + (tid & 7) * 8); r3 = *(const u32x4*)(KHg + (size_t)mc_ * 8192 + ((tid >> 3) + 64) * 64 + (tid & 7) * 8); \
        r4 = *(const u32x4*)(Pg + (size_t)mc_ * 4096 + (tid >> 3) * 64 + (tid & 7) * 8); \
        r5 = mc_ < 4 ? *(const u32x4*)(vtc + mc_ * 64) : *(const u32x4*)(vtl + (mc_ - 4) * 64); \
        re = *(const f32x4*)(Eg + (size_t)mc_ * 128 + (tid & 31) * 4); } while (0)
#define CH_WRITE_(buf, r0, r1, r2, r3, r4, r5, re) do { LAS unsigned char* b_ = lds + (buf) * CH_BUF; \
        *(LAS u32x4*)(b_ + (tid >> 4) * 272 + (tid & 15) * 16) = r0; *(LAS u32x4*)(b_ + ((tid >> 4) + 32) * 272 + (tid & 15) * 16) = r1; \
        *(LAS u32x4*)(b_ + CH_KH + (tid >> 3) * 144 + (tid & 7) * 16) = r2; *(LAS u32x4*)(b_ + CH_KH + ((tid >> 3) + 64) * 144 + (tid & 7) * 16) = r3; \
        *(LAS u32x4*)(b_ + CH_P + (tid >> 3) * 144 + (tid & 7) * 16) = r4; *(LAS u32x4*)(b_ + CH_V + (tid >> 3) * 144 + (tid & 7) * 16) = r5; \
        if (tid < 32) *(LAS f32x4*)(b_ + CH_E + tid * 16) = re; } while (0)
#define SET_A ra0, ra1, ra2, ra3, ra4, ra5, rae
#define SET_B rb0, rb1, rb2, rb3, rb4, rb5, rbe
#define CH_ISSUE(ci, set) CH_ISSUE_X(ci, set)
#define CH_ISSUE_X(ci, ...) CH_ISSUE_(ci, __VA_ARGS__)
#define CH_WRITE(buf, set) CH_WRITE_X(buf, set)
#define CH_WRITE_X(buf, ...) CH_WRITE_(buf, __VA_ARGS__)
    CH_ISSUE(0, SET_A); CH_WRITE(0, SET_A); CH_ISSUE(1, SET_B);
    f32x4 S[8];
#pragma unroll
    for (int dt = 0; dt < 8; ++dt) S[dt] = (f32x4){0.f, 0.f, 0.f, 0.f};
    if (wave < 4) {
#pragma unroll
        for (int dt = 0; dt < 8; ++dt) *(LAS u32x2*)(st + fr * 272 + (dt * 16 + fq * 4) * 2) = (u32x2){0u, 0u};
    }
    __syncthreads();
    auto step = [&](const int ci, LAS unsigned char* cur) {
        const int w4 = wave & 3;
        bf16x8 a_v[2];
#pragma unroll
        for (int ks = 0; ks < 2; ++ks) a_v[ks] = *(const LAS bf16x8*)(cur + CH_V + (w4 * 16 + fr) * 144 + ks * 64 + fq * 16);
        if (wave >= 4) {
            const int mc = dir == 0 ? ci : (ci < 4 ? 3 - ci : 71 - ci);
            const int rb = mc < 4 ? ROWS_LAT + b * CTXL + mc * 64 : b * T + (mc - 4) * 64;
            const LAS unsigned char* sti = st + (ci & 1) * (4 * 4352);
            bf16x8 a_st[4];
#pragma unroll
            for (int ks = 0; ks < 4; ++ks) a_st[ks] = *(const LAS bf16x8*)(sti + fr * 272 + ks * 64 + fq * 16);
#pragma unroll
            for (int ih = 0; ih < 2; ++ih) {
                bf16x8 bq[2][4], bp[2][2]; f32x4 o[2];
#pragma unroll
                for (int i2 = 0; i2 < 2; ++i2) { const int it = ih * 2 + i2; o[i2] = (f32x4){0.f, 0.f, 0.f, 0.f};
#pragma unroll
                    for (int ks = 0; ks < 4; ++ks) bq[i2][ks] = *(const LAS bf16x8*)(cur + (it * 16 + fr) * 272 + ks * 64 + fq * 16);
#pragma unroll
                    for (int ks = 0; ks < 2; ++ks) bp[i2][ks] = *(const LAS bf16x8*)(cur + CH_P + (it * 16 + fr) * 144 + ks * 64 + fq * 16); }
#pragma unroll
                for (int ks = 0; ks < 4; ++ks)
#pragma unroll
                    for (int i2 = 0; i2 < 2; ++i2) o[i2] = __builtin_amdgcn_mfma_f32_16x16x32_bf16(a_st[ks], bq[i2][ks], o[i2], 0, 0, 0);
#pragma unroll
                for (int ks = 0; ks < 2; ++ks)
#pragma unroll
                    for (int i2 = 0; i2 < 2; ++i2) o[i2] = __builtin_amdgcn_mfma_f32_16x16x32_bf16(a_v[ks], bp[i2][ks], o[i2], 0, 0, 0);
#pragma unroll
                for (int i2 = 0; i2 < 2; ++i2) { u32x2 ow; ow.x = pk2(o[i2][0], o[i2][1]); ow.y = pk2(o[i2][2], o[i2][3]); *(u32x2*)(Og + (size_t)(rb + (ih * 2 + i2) * 16 + fr) * 1024) = ow; }
            }
        } else {
            LAS unsigned char* sto = st + ((ci + 1) & 1) * (4 * 4352);
#pragma unroll
            for (int hh = 0; hh < 2; ++hh) {
                f32x4 ev[4]; bf16x8 ak[4][2];
#pragma unroll
                for (int d4 = 0; d4 < 4; ++d4) { const int dt = hh * 4 + d4; ev[d4] = *(const LAS f32x4*)(cur + CH_E + (dt * 16 + fq * 4) * 4);
#pragma unroll
                    for (int ks = 0; ks < 2; ++ks) ak[d4][ks] = *(const LAS bf16x8*)(cur + CH_KH + (dt * 16 + fr) * 144 + ks * 64 + fq * 16); }
#pragma unroll
                for (int d4 = 0; d4 < 4; ++d4) S[hh * 4 + d4] = S[hh * 4 + d4] * ev[d4];
#pragma unroll
                for (int ks = 0; ks < 2; ++ks)
#pragma unroll
                    for (int d4 = 0; d4 < 4; ++d4) S[hh * 4 + d4] = __builtin_amdgcn_mfma_f32_16x16x32_bf16(ak[d4][ks], a_v[ks], S[hh * 4 + d4], 0, 0, 0);
            }
#pragma unroll
            for (int dt = 0; dt < 8; ++dt) { u32x2 w2; w2.x = pk2(S[dt][0], S[dt][1]); w2.y = pk2(S[dt][2], S[dt][3]); *(LAS u32x2*)(sto + fr * 272 + (dt * 16 + fq * 4) * 2) = w2; }
        }
    };
    for (int ci = 0; ci < 68; ci += 2) {
        CH_ISSUE(ci + 2, SET_A);
        step(ci, lds);
        CH_WRITE(1, SET_B);
        __syncthreads();
        CH_ISSUE(ci + 3, SET_B);
        step(ci + 1, lds + CH_BUF);
        CH_WRITE(0, SET_A);
        __syncthreads();
    }
#undef SET_A
#undef SET_B
#undef CH_ISSUE_
#undef CH_WRITE_
#undef CH_ISSUE_X
#undef CH_WRITE_X
#undef CH_ISSUE
#undef CH_WRITE
}
__device__ __forceinline__ void mix_phase(const Params& p, int l, int nrows) {
    const int tid_ = opaque_tid(), lane = tid_ & 63, wave = tid_ >> 6;
    unsigned char* C = p.ws + OFF_C;
    const bf16_t* of = (const bf16_t*)(C + C_OF); const bf16_t* ob = (const bf16_t*)(C + C_OB);
    const bf16_t* pg = (const bf16_t*)(C + C_PG); const bf16_t* pu = (const bf16_t*)(C + C_PU);
    bf16_t* mixed = (bf16_t*)(p.ws + OFF_H);
    const f32x4 ng = *(const f32x4*)(p.gla_norm_g + l * 256 + lane * 4);
    const int stride = gridDim.x * 8;
    int r = blockIdx.x * 8 + wave;
    u32x2 nof[4], nob[4]; u32x2 ngw[4];
#define MIX_LOAD(rr) do { _Pragma("unroll") for (int h = 0; h < 4; ++h) { const size_t o4_ = (size_t)(rr) * 1024 + h * 256 + lane * 4; nof[h] = *(const u32x2*)(of + o4_); nob[h] = *(const u32x2*)(ob + o4_); ngw[h] = *(const u32x2*)(pg + o4_); } } while (0)
    if (r < nrows) MIX_LOAD(r);
    for (; r < nrows; r += stride) {
        u32x2 cof[4], cob[4]; u32x2 cgw[4];
#pragma unroll
        for (int h = 0; h < 4; ++h) { cof[h] = nof[h]; cob[h] = nob[h]; cgw[h] = ngw[h]; }
        int t, seg0, seg1, r0;
        if (r < ROWS_LAT) { t = r & (T - 1); r0 = r - t; seg0 = t & ~63; seg1 = seg0 + 63; } else { t = (r - ROWS_LAT) & (CTXL - 1); r0 = r - t; seg0 = 0; seg1 = CTXL - 1; }
        u32x4 pw0[4], pw1[16], uc[2];
#pragma unroll
        for (int k = 0; k < 4; ++k) { const int tc = min(max(t - 2 + k, seg0), seg1); pw0[k] = *(const u32x4*)(pu + (size_t)(r0 + tc) * 1024 + lane * 8); }
#pragma unroll
        for (int k = 0; k < 16; ++k) { const int tc = min(max(t - 8 + k, seg0), seg1); pw1[k] = *(const u32x4*)(pu + (size_t)(r0 + tc) * 1024 + 512 + lane * 8); }
#pragma unroll
        for (int it = 0; it < 2; ++it) uc[it] = *(const u32x4*)(pu + (size_t)r * 1024 + it * 512 + lane * 8);
        { const int rn = min(r + stride, nrows - 1); MIX_LOAD(rn); }
#pragma unroll
        for (int h = 0; h < 4; ++h) {
            const f32x4 o = (f32x4){bflo(cof[h].x) + bflo(cob[h].x), bfhi(cof[h].x) + bfhi(cob[h].x), bflo(cof[h].y) + bflo(cob[h].y), bfhi(cof[h].y) + bfhi(cob[h].y)};
            const float ss = wave_sum((o[0] * o[0] + o[1] * o[1]) + (o[2] * o[2] + o[3] * o[3]));
            const float rinv = 1.f / sqrtf(ss * (1.f / 256.f) + 1e-6f);
            const u32x2 gw = cgw[h];
            const f32x4 y = o * rinv * ng;
            u32x2 w; w.x = pk2(y[0] * siluf(bflo(gw.x)), y[1] * siluf(bfhi(gw.x))); w.y = pk2(y[2] * siluf(bflo(gw.y)), y[3] * siluf(bfhi(gw.y)));
            *(u32x2*)(mixed + (size_t)r * D + h * 256 + lane * 4) = w;
        }
#pragma unroll
        for (int it = 0; it < 2; ++it) {
            const int c = it * 512 + lane * 8, gi = c >> 8, hw = 1 << gi;
            const int lo = max(t - hw, seg0), hi = min(t + hw - 1, seg1);
            const int kmax = it == 0 ? 4 : 16, tb = t - kmax / 2;
            float s[8];
#pragma unroll
            for (int j = 0; j < 8; ++j) s[j] = 0.f;
#pragma unroll
            for (int k = 0; k < kmax; ++k) { const int tt = tb + k; const bool ok = tt >= lo && tt <= hi;
                u32x4 uw = it == 0 ? pw0[k & 3] : pw1[k];
                if (!ok) uw = (u32x4){0u, 0u, 0u, 0u};
                s[0] += bflo(uw.x); s[1] += bfhi(uw.x); s[2] += bflo(uw.y); s[3] += bfhi(uw.y); s[4] += bflo(uw.z); s[5] += bfhi(uw.z); s[6] += bflo(uw.w); s[7] += bfhi(uw.w); }
            const float inv = 1.f / (float)(hi - lo + 1);
            const u32x4 ucv = uc[it];
            u32x4 w; w.x = pk2(s[0] * inv - bflo(ucv.x), s[1] * inv - bfhi(ucv.x)); w.y = pk2(s[2] * inv - bflo(ucv.y), s[3] * inv - bfhi(ucv.y));
            w.z = pk2(s[4] * inv - bflo(ucv.z), s[5] * inv - bfhi(ucv.z)); w.w = pk2(s[6] * inv - bflo(ucv.w), s[7] * inv - bfhi(ucv.w));
            *(u32x4*)(mixed + (size_t)r * D + 1024 + c) = w;
        }
    }
#undef MIX_LOAD
}


#define XB_TMO      128
#define XB_XCNT(j)  (256  + 64 * (j))
#define XB_XSUB(j)  (1280 + 64 * (j))
#define XB_XGEN(j)  (2304 + 64 * (j))
#define XB_TOP      3328
#define XB_TOPGEN   3392
#define XCD_BAR_WORDS 3456
#define XB_SPIN_CAP (1u << 18)
__device__ __forceinline__ unsigned xb_ld(unsigned* p)              { return __hip_atomic_load(p, __ATOMIC_RELAXED, __HIP_MEMORY_SCOPE_AGENT); }
__device__ __forceinline__ unsigned xb_add(unsigned* p, unsigned v) { return __hip_atomic_fetch_add(p, v, __ATOMIC_RELAXED, __HIP_MEMORY_SCOPE_AGENT); }
__device__ __forceinline__ unsigned xb_xcc_id() { return (unsigned)__builtin_amdgcn_s_getreg((3 << 11) | 20) & 0xFu; }
#define XB_SPIN(cond, bar) do { unsigned _sp = 0; while (cond) { __builtin_amdgcn_s_sleep(1); \
    if ((++_sp & 255u) == 0u) { if (xb_ld(&(bar)[XB_TMO])) break; if (_sp > XB_SPIN_CAP) { atomicAdd(&(bar)[XB_TMO], 1u); break; } } } } while (0)
struct XcdBarrier { unsigned* bar; unsigned x; volatile LAS unsigned* st; };
__device__ __forceinline__ void xcd_barrier_complete(unsigned* bar, unsigned x, unsigned& nloc, unsigned& nx) {
    const unsigned G = gridDim.x * gridDim.y * gridDim.z;
    unsigned sum, cnt, mine, sp = 0u;
    for (;;) {
        sum = 0u; cnt = 0u; mine = 0u;
#pragma unroll
        for (unsigned j = 0; j < 16; ++j) { const unsigned c = xb_ld(&bar[XB_XCNT(j)]); sum += c; cnt += (c > 0u) ? 1u : 0u; mine = (j == x) ? c : mine; }
        if (sum == G) break;
        __builtin_amdgcn_s_sleep(1);
        if ((++sp & 255u) == 0u) { if (xb_ld(&bar[XB_TMO])) break; if (sp > XB_SPIN_CAP) { atomicAdd(&bar[XB_TMO], 1u); break; } }
    }
    nloc = mine > 0u ? mine : 1u; nx = cnt > 0u ? cnt : 1u;
}
__device__ __forceinline__ void xcd_barrier(const XcdBarrier& b) {
    asm volatile("s_waitcnt vmcnt(0)" ::: "memory");
    __syncthreads();
    if (threadIdx.x == 0) {
        unsigned* bar = b.bar;
        __builtin_amdgcn_s_waitcnt(0);
        unsigned nloc = b.st[0], nx = b.st[1];
        if (nloc == 0u) { xcd_barrier_complete(bar, b.x, nloc, nx); b.st[0] = nloc; b.st[1] = nx; }
        const unsigned old = xb_add(&bar[XB_XSUB(b.x)], 1u);
        const unsigned gen = old / nloc;
        if (old + 1u == (gen + 1u) * nloc) {
            __builtin_amdgcn_fence(__ATOMIC_RELEASE, "agent");
            asm volatile("s_waitcnt vmcnt(0)" ::: "memory");
            const unsigned og = xb_add(&bar[XB_TOP], 1u);
            const unsigned tg = og / nx;
            if (og + 1u == (tg + 1u) * nx) xb_add(&bar[XB_TOPGEN], 1u);
            else XB_SPIN(xb_ld(&bar[XB_TOPGEN]) == tg, bar);
            __builtin_amdgcn_fence(__ATOMIC_ACQUIRE, "agent");
            xb_add(&bar[XB_XGEN(b.x)], 1u);
            asm volatile("s_waitcnt vmcnt(0)" ::: "memory");
        } else {
            XB_SPIN(xb_ld(&bar[XB_XGEN(b.x)]) == gen, bar);
            __builtin_amdgcn_fence(__ATOMIC_ACQUIRE, "agent");
            asm volatile("s_waitcnt vmcnt(0)" ::: "memory");
        }
    }
    __syncthreads();
}

typedef const __attribute__((address_space(4))) Params KParams;
#if defined(__HIP_DEVICE_COMPILE__)
__device__ __forceinline__ Params load_params() { KParams* kp = (KParams*)__builtin_amdgcn_kernarg_segment_ptr(); asm volatile("" : "+s"(kp)); return *kp; }
#else
__device__ Params load_params();
#endif
#ifndef PHASE_MASK
#define PHASE_MASK 0xFFFF
#endif
#ifndef DUP_MASK
#define DUP_MASK 0
#endif
#define PH(i) if (PHASE_MASK & (1 << (i))) for (int dup_ = 0; dup_ <= ((DUP_MASK >> (i)) & 1); ++dup_)
__global__ void __launch_bounds__(512, 2) mega(Params p_unused) {
    extern __shared__ __attribute__((aligned(16))) unsigned char shm[];
    cg::grid_group grid = cg::this_grid();
    LAS unsigned char* lds = (LAS unsigned char*)shm;
    LAS float* ldsf = (LAS float*)shm;
    const int G = gridDim.x, bid = blockIdx.x;
#define WSP(off) (p.ws + (off))
    volatile LAS unsigned* xst = (volatile LAS unsigned*)(lds + 144384);
    if (threadIdx.x < 4) xst[threadIdx.x] = 0u;
    __syncthreads();
    { const Params p = load_params(); if (threadIdx.x == 0) (void)xb_add(&((unsigned*)WSP(OFF_BAR))[XB_XCNT(xb_xcc_id())], 1u); }
#define GSYNC() do { const Params pb_ = load_params(); XcdBarrier xb_; xb_.bar = (unsigned*)(pb_.ws + OFF_BAR); xb_.x = xb_xcc_id(); xb_.st = xst; xcd_barrier(xb_); } while (0)
#define CP(off) (p.ws + OFF_C + (off))

    PH(0) { const Params p = load_params();
      for (int it = bid; it < 192; it += G) modp_task(p, 0, it, ldsf);
      convert_phase(p, 0, ldsf, 0, 4352, 0, G); }
    if (gridDim.x == 0x7fffffffu) grid.sync();
    GSYNC();
    PH(1) { const Params p = load_params(); const float* modp = (const float*)WSP(OFF_MODP); float* MOD = (float*)WSP(OFF_MOD);
      for (int i = bid * 512 + threadIdx.x; i < 5 * 12288; i += G * 512) { const int n = i % 12288; float s = p.b_ada[n];
#pragma unroll 8
          for (int k = 0; k < 32; ++k) s += modp[(size_t)k * (2 * 5 * 12288) + i];
          MOD[i] = s; } }
    GSYNC();
    PH(2) { const Params p = load_params(); ln_phase(ROWS, p.x, p.ctx, nullptr, nullptr, nullptr, nullptr, (const float*)WSP(OFF_MOD), 0, 1, (bf16_t*)WSP(OFF_H)); }
    GSYNC();

    for (int l = 0; l < 2; ++l) {
        const int nrows = l == 0 ? ROWS : ROWS_LAT;
        PH(3) { const Params p = load_params(); pg8::StaticOrder S;
          pg8::Gemm g{(const bf16_t*)WSP(OFF_H), (const bf16_t*)WSP(OFF_W), ROWS, NIN, D, D, D, 0}; S.init(g.M, g.N, opaque_s(G), opaque_s(bid));
          EpiIn e{(bf16_t*)CP(C_PK), (bf16_t*)CP(C_VTL), (bf16_t*)CP(C_VTC), (bf16_t*)CP(C_PQ), (bf16_t*)CP(C_PG), (bf16_t*)CP(C_PU), (float*)CP(C_LR)};
          pg8::gemm_phase(lds, g, S, e);
          if (bid >= 132) { convert_phase(p, l, ldsf, 4352, l == 0 ? 4352 + 3000 : CVT_SPLIT, 132, G - 132); convert_phase(p, l, ldsf, CVT_ITEMS - 128, CVT_ITEMS, 132, G - 132); } }
        GSYNC();
        PH(4) { const Params p = load_params(); gla_prep(p, l, lds); }
        GSYNC();
        PH(12) { const Params p = load_params(); gla_chain(p, lds);
          if (bid >= 128) {
            if (bid < 160) {
              pg8::StaticOrder S; bf16_t* wo = (bf16_t*)WSP(OFF_W) + NW_IN;
              pg8::Gemm g{wo + 1024, (const bf16_t*)WSP(OFF_W) + NW_IN + NW_OUT + NW_1 + NW_2, D, 1024, 256, D, 256, 512}; S.init(g.M, g.N, 32, opaque_s(bid - 128));
              EpiPool e{wo, nullptr};
              pg8::gemm_phase(lds, g, S, e); }
            if (l == 0) convert_phase(p, 0, ldsf, 4352 + 3000, 14592, 128, G - 128);
            else convert_phase(p, l, ldsf, CVT_SPLIT, CVT_ITEMS - 128, 128, G - 128);
            if (l == 0 && bid >= 160) { __syncthreads(); for (int it = bid - 160; it < 192; it += G - 160) modp_task(p, 1, it, ldsf); } } }
        GSYNC();
        PH(5) { const Params p = load_params(); mix_phase(p, l, nrows);
          if (l == 0) { const float* modp = (const float*)WSP(OFF_MODP) + 5 * 12288; float* MOD1 = (float*)WSP(OFF_MOD) + 5 * 12288;
            for (int i = bid * 512 + threadIdx.x; i < 5 * 12288; i += G * 512) { float sacc = p.b_ada[12288 + i % 12288];
#pragma unroll 8
              for (int k = 0; k < 32; ++k) sacc += modp[(size_t)k * (2 * 5 * 12288) + i];
              MOD1[i] = sacc; } } }
        GSYNC();
        PH(7) { const Params p = load_params(); pg8::StaticOrder S;
          pg8::Gemm g{(const bf16_t*)WSP(OFF_H), (const bf16_t*)WSP(OFF_W) + NW_IN, nrows, D, D, D, D, 0};
          if (l == 0) S.init_split(ROWS_LAT, g.N, opaque_s(G), opaque_s(bid), 4, 8); else S.init(g.M, g.N, opaque_s(G), opaque_s(bid));
          EpiDelta e{(bf16_t*)CP(C_PK), (const float*)WSP(OFF_MOD) + (size_t)l * 5 * 12288 + 2 * D, nullptr, (float*)CP(C_PART2)};
          pg8::gemm_phase(lds, g, S, e); }
        GSYNC();
        PH(8) { const Params p = load_params(); float* XB = (float*)WSP(OFF_XB);
          const float* modl = (const float*)WSP(OFF_MOD) + (size_t)l * 5 * 12288;
          ln_phase(nrows, l == 0 ? p.x : XB, l == 0 ? p.ctx : XB + (size_t)ROWS_LAT * D, p.ln1_g + l * D, p.ln1_b + l * D, XB, XB + (size_t)ROWS_LAT * D, modl, 3, 4, (bf16_t*)WSP(OFF_H),
                   (const bf16_t*)CP(C_PK), l == 0 ? (const float*)CP(C_PART2) : nullptr, modl + (4 * 6 + 2) * D, nullptr); }
        GSYNC();
        PH(9) { const Params p = load_params(); pg8::StaticOrder S;
          pg8::Gemm g{(const bf16_t*)WSP(OFF_H), (const bf16_t*)WSP(OFF_W) + NW_IN + NW_OUT, nrows, DFF, D, D, D, 0}; S.init(g.M, g.N, opaque_s(G), opaque_s(bid));
          EpiMlp1 e{(bf16_t*)CP(C_A1), p.b_mlp1 + l * DFF};
          pg8::gemm_phase(lds, g, S, e);
          if (l == 0 && bid >= 128) { convert_phase(p, 1, ldsf, 0, 4352, 128, G - 128); convert_phase(p, 0, ldsf, 14592, 22784, 128, G - 128); } }
        GSYNC();
        PH(10) { const Params p = load_params(); pg8::StaticOrder S;
          pg8::Gemm g{(const bf16_t*)CP(C_A1), (const bf16_t*)WSP(OFF_W) + NW_IN + NW_OUT + NW_1, nrows, D, DFF, DFF, DFF, 0};
          if (l == 0) S.init_split(ROWS_LAT, g.N, opaque_s(G), opaque_s(bid), 4, 8); else S.init(g.M, g.N, opaque_s(G), opaque_s(bid));
          EpiDelta e{(bf16_t*)WSP(OFF_H), (const float*)WSP(OFF_MOD) + (size_t)l * 5 * 12288 + 5 * D, p.b_mlp2 + l * D, (float*)CP(C_PART4)};
          pg8::gemm_phase(lds, g, S, e); }
        GSYNC();
        PH(11) { const Params p = load_params(); float* XB = (float*)WSP(OFF_XB);
          if (l == 0) {
            ln_phase(ROWS, XB, XB + (size_t)ROWS_LAT * D, p.ln2_g, p.ln2_b, XB, XB + (size_t)ROWS_LAT * D, (const float*)WSP(OFF_MOD) + (size_t)5 * 12288, 0, 1, (bf16_t*)WSP(OFF_H),
                     (const bf16_t*)WSP(OFF_H), (const float*)CP(C_PART4), (const float*)WSP(OFF_MOD) + (4 * 6 + 5) * D, p.b_mlp2);
          } else {
            ln_phase(ROWS_LAT, XB, nullptr, p.ln2_g + D, p.ln2_b + D, p.out, nullptr, nullptr, 0, 0, nullptr, (const bf16_t*)WSP(OFF_H));
          } }
        if (l == 0) GSYNC();
    }
}

extern "C" void kernel_launch(void* const* d_in, const int* in_sizes, int n_in, void* d_out, int out_size, void* d_ws, size_t ws_size, hipStream_t stream) {
    constexpr int LDS_BYTES = 144384 + 16;
    static int grid = 0;
    if (grid == 0) {
        if (n_in != 21 || ws_size < WS_NEED) { fprintf(stderr, "kernel_launch: need 21 inputs and %zu bytes of workspace; got %d, %zu\n", (size_t)WS_NEED, n_in, ws_size); grid = -1; return; }
        int dev = 0, cus = 0, per_cu = 0;
        hipGetDevice(&dev); hipDeviceGetAttribute(&cus, hipDeviceAttributeMultiprocessorCount, dev);
        if (hipFuncSetAttribute((const void*)mega, hipFuncAttributeMaxDynamicSharedMemorySize, LDS_BYTES) != hipSuccess) { fprintf(stderr, "kernel_launch: hipFuncSetAttribute failed\n"); grid = -1; return; }
        if (hipOccupancyMaxActiveBlocksPerMultiprocessor(&per_cu, (const void*)mega, 512, LDS_BYTES) != hipSuccess || per_cu < 1) { fprintf(stderr, "kernel_launch: occupancy query gave %d\n", per_cu); per_cu = 1; }
        (void)hipGetLastError();
        grid = cus * 1;
        fprintf(stderr, "kernel_launch: grid %d (per_cu %d)\n", grid, per_cu);
    }
    if (grid < 0) return;
    if (hipMemsetAsync((unsigned char*)d_ws + OFF_BAR, 0, 16384, stream) != hipSuccess) { fprintf(stderr, "kernel_launch: memset failed\n"); return; }
    Params p{};
    const float** pp = (const float**)&p;
    for (int i = 0; i < 21; ++i) pp[i] = (const float*)d_in[i];
    p.out = (float*)d_out; p.ws = (unsigned char*)d_ws;
    void* args[] = {&p};
    hipError_t e = hipLaunchCooperativeKernel((const void*)mega, dim3(grid), dim3(512), args, LDS_BYTES, stream);
    if (e != hipSuccess) fprintf(stderr, "kernel_launch: cooperative launch failed: %s (grid %d)\n", hipGetErrorString(e), grid);
}
```
